# Optimizing an MI355X kernel written in HIP

```python
import math
import jax, jax.numpy as jnp
from jax import lax
import numpy as np

D_MODEL = 2048
BATCH = 4
SEQ = 8192
DEPTH = 1

MIX_WIDTH = D_MODEL
ATTN_WIDTH = D_MODEL // 2
HEAD_DIM = 128
N_HEADS = ATTN_WIDTH // HEAD_DIM
DILATION_PATTERNS = ((128, 1), (512, 4), (2048, 16))
SSM_WIDTH = MIX_WIDTH - ATTN_WIDTH
SSM_GROUP = 16
N_SSM_GROUPS = SSM_WIDTH // SSM_GROUP
STATE_DIM = 64
SSM_CHUNK = 128
IN_WIDTH = 3 * ATTN_WIDTH + SSM_WIDTH
D_FF = 4 * D_MODEL
N_MOD = 6
EPS = 1e-6
DT_MIN = 1e-3
DT_MAX = 1e-1

kernel_name = "hymba_dilated_attn_s5_sqrelu_adaln"


def rms_norm(x, g):
    xf = x.astype(jnp.float32)
    y = xf * lax.rsqrt(jnp.mean(xf * xf, axis=-1, keepdims=True) + EPS) * g.astype(jnp.float32)
    return y.astype(x.dtype)


def alibi_slopes(n_heads):
    return 2.0 ** (-8.0 * (jnp.arange(n_heads, dtype=jnp.float32) + 1.0) / n_heads)


def dilated_pattern(q, k, v, slopes, window, dilation):
    b, s, h, e = q.shape
    n = window // dilation
    L = s // dilation
    nb = -(-L // n)
    Lp = nb * n

    def to_blocks(t):
        t = t.reshape(b, L, dilation, h, e)
        t = jnp.pad(t, ((0, 0), (0, Lp - L), (0, 0), (0, 0), (0, 0)))
        return t.reshape(b, nb, n, dilation, h, e)

    def with_prev(t):
        prev = jnp.pad(t, ((0, 0), (1, 0), (0, 0), (0, 0), (0, 0), (0, 0)))[:, :-1]
        return jnp.concatenate([prev, t], axis=2)

    qb = to_blocks(q)
    kw = with_prev(to_blocks(k))
    vw = with_prev(to_blocks(v))
    scores = jnp.einsum('bnqrhe,bnkrhe->bnrhqk', qb, kw) * (HEAD_DIM ** -0.5)

    qi = jnp.arange(n)[:, None]
    ki = jnp.arange(2 * n)[None, :]
    steps = qi - ki + n
    key_idx = jnp.arange(nb)[:, None, None] * n - n + ki
    valid = (steps >= 0) & (steps <= n) & (key_idx >= 0)
    bias = -slopes[:, None, None] * (steps * dilation).astype(jnp.float32)
    scores = scores + bias[None, None, None]
    scores = jnp.where(valid[None, :, None, None], scores, -jnp.inf)

    m = jnp.max(scores, axis=-1, keepdims=True)
    p = jnp.exp(scores - m)
    denom = jnp.sum(p, axis=-1, keepdims=True)
    out = jnp.einsum('bnrhqk,bnkrhe->bnqrhe', p, vw)
    denom_q = jnp.moveaxis(denom[..., 0], -1, 2)
    lse_q = jnp.moveaxis(m[..., 0], -1, 2) + jnp.log(denom_q)
    out = out / denom_q[..., None]
    out = out.reshape(b, Lp, dilation, h, e)[:, :L].reshape(b, s, h, e)
    lse = lse_q.reshape(b, Lp, dilation, h)[:, :L].reshape(b, s, h)
    return out, lse


def dilated_attention(q, k, v):
    slopes = alibi_slopes(N_HEADS)
    outs, lses = [], []
    for window, dilation in DILATION_PATTERNS:
        o, l = dilated_pattern(q, k, v, slopes, window, dilation)
        outs.append(o)
        lses.append(l)
    w = jax.nn.softmax(jnp.stack(lses, axis=0), axis=0)
    return jnp.sum(w[..., None] * jnp.stack(outs, axis=0), axis=0)


def _ssm_combine(e_i, e_j):
    a_i, b_i = e_i
    a_j, b_j = e_j
    return a_j * a_i, a_j * b_i + b_j


def s5_mixer(u, lam_re, lam_im, log_step, b_re, b_im, c_re, c_im, d_skip):
    bsz, s, _ = u.shape
    uf = u.astype(jnp.float32).reshape(bsz, s, N_SSM_GROUPS, SSM_GROUP)
    lam = lax.complex(lam_re.astype(jnp.float32), lam_im.astype(jnp.float32))
    step = jnp.exp(log_step.astype(jnp.float32))[:, None]
    a_bar = jnp.exp(lam * step)
    b_mat = lax.complex(b_re.astype(jnp.float32), b_im.astype(jnp.float32))
    b_bar = ((a_bar - 1.0) / lam)[..., None] * b_mat
    c_mat = lax.complex(c_re.astype(jnp.float32), c_im.astype(jnp.float32))
    n_chunks = s // SSM_CHUNK
    u_chunks = uf.reshape(bsz, n_chunks, SSM_CHUNK, N_SSM_GROUPS, SSM_GROUP).transpose(1, 0, 2, 3, 4)
    a_full = jnp.broadcast_to(a_bar, (bsz, SSM_CHUNK, N_SSM_GROUPS, STATE_DIM))

    def segment(h, u_c):
        bu = jnp.einsum('blgi,gpi->blgp', u_c.astype(jnp.complex64), b_bar)
        bu = bu.at[:, 0].add(a_bar * h)
        _, hs = lax.associative_scan(_ssm_combine, (a_full, bu), axis=1)
        y = jnp.real(jnp.einsum('blgp,gip->blgi', hs, c_mat))
        return hs[:, -1], y

    h0 = jnp.zeros((bsz, N_SSM_GROUPS, STATE_DIM), jnp.complex64)
    _, ys = lax.scan(segment, h0, u_chunks)
    y = ys.transpose(1, 0, 2, 3, 4).reshape(bsz, s, N_SSM_GROUPS, SSM_GROUP)
    y = y + d_skip.astype(jnp.float32).reshape(N_SSM_GROUPS, SSM_GROUP) * uf
    return y.reshape(bsz, s, SSM_WIDTH)


def hybrid_layer(x, c, w_ada, b_ada, norm1_g, w_in, q_norm_g, k_norm_g, lam_re, lam_im,
                 log_step, b_re, b_im, c_re, c_im, d_skip, w_glu, b_glu, attn_out_g,
                 ssm_out_g, w_out, norm2_g, w_ff1, w_ff2):
    bsz, s, _ = x.shape
    mod = (jax.nn.silu(c) @ w_ada + b_ada)[:, None, :]
    sh1, sc1, g1, sh2, sc2, g2 = jnp.split(mod, N_MOD, axis=-1)

    h = rms_norm(x, norm1_g) * (1.0 + sc1) + sh1
    proj = h @ w_in
    q, k, v, u = jnp.split(proj, [ATTN_WIDTH, 2 * ATTN_WIDTH, 3 * ATTN_WIDTH], axis=-1)
    q = rms_norm(q.reshape(bsz, s, N_HEADS, HEAD_DIM), q_norm_g).astype(jnp.float32)
    k = rms_norm(k.reshape(bsz, s, N_HEADS, HEAD_DIM), k_norm_g).astype(jnp.float32)
    v = v.reshape(bsz, s, N_HEADS, HEAD_DIM).astype(jnp.float32)
    attn = dilated_attention(q, k, v).reshape(bsz, s, ATTN_WIDTH).astype(x.dtype)

    y = jax.nn.gelu(s5_mixer(u, lam_re, lam_im, log_step, b_re, b_im, c_re, c_im, d_skip)).astype(x.dtype)
    ssm = y * jax.nn.sigmoid(y @ w_glu + b_glu)

    mixed = jnp.concatenate([rms_norm(attn, attn_out_g), rms_norm(ssm, ssm_out_g)], axis=-1) @ w_out
    x = x + g1 * mixed

    h2 = rms_norm(x, norm2_g) * (1.0 + sc2) + sh2
    ff = jnp.square(jax.nn.relu(h2 @ w_ff1)) @ w_ff2
    return x + g2 * ff


def setup_inputs(seed: int = 0) -> dict:
    key = jax.random.key(seed)
    ks = jax.random.split(key, 26)
    f32 = jnp.float32
    nrm = lambda k, shape, scale: jax.random.normal(k, shape, f32) * scale
    G, P = N_SSM_GROUPS, STATE_DIM
    lam_im_base = jnp.pi * jnp.arange(P, dtype=f32)
    return {
        "x": nrm(ks[0], (BATCH, SEQ, D_MODEL), 1.0),
        "c": nrm(ks[1], (BATCH, D_MODEL), 1.0),
        "w_ada": nrm(ks[2], (DEPTH, D_MODEL, N_MOD * D_MODEL), 0.5 * D_MODEL ** -0.5),
        "b_ada": nrm(ks[3], (DEPTH, N_MOD * D_MODEL), 0.01),
        "norm1_g": 1.0 + nrm(ks[4], (DEPTH, D_MODEL), 0.01),
        "w_in": nrm(ks[5], (DEPTH, D_MODEL, IN_WIDTH), D_MODEL ** -0.5),
        "q_norm_g": 1.0 + nrm(ks[6], (DEPTH, HEAD_DIM), 0.01),
        "k_norm_g": 1.0 + nrm(ks[7], (DEPTH, HEAD_DIM), 0.01),
        "lam_re": -0.5 + nrm(ks[8], (DEPTH, G, P), 0.01),
        "lam_im": lam_im_base + nrm(ks[9], (DEPTH, G, P), 0.01),
        "log_step": jax.random.uniform(ks[10], (DEPTH, G), f32, math.log(DT_MIN), math.log(DT_MAX)),
        "b_re": nrm(ks[11], (DEPTH, G, P, SSM_GROUP), (2.0 * SSM_GROUP) ** -0.5),
        "b_im": nrm(ks[12], (DEPTH, G, P, SSM_GROUP), (2.0 * SSM_GROUP) ** -0.5),
        "c_re": nrm(ks[13], (DEPTH, G, SSM_GROUP, P), (2.0 * P) ** -0.5),
        "c_im": nrm(ks[14], (DEPTH, G, SSM_GROUP, P), (2.0 * P) ** -0.5),
        "d_skip": nrm(ks[15], (DEPTH, SSM_WIDTH), 1.0),
        "w_glu": nrm(ks[16], (DEPTH, SSM_WIDTH, SSM_WIDTH), SSM_WIDTH ** -0.5),
        "b_glu": nrm(ks[17], (DEPTH, SSM_WIDTH), 0.01),
        "attn_out_g": 1.0 + nrm(ks[18], (DEPTH, ATTN_WIDTH), 0.01),
        "ssm_out_g": 1.0 + nrm(ks[19], (DEPTH, SSM_WIDTH), 0.01),
        "w_out": nrm(ks[20], (DEPTH, MIX_WIDTH, D_MODEL), MIX_WIDTH ** -0.5),
        "norm2_g": 1.0 + nrm(ks[21], (DEPTH, D_MODEL), 0.01),
        "w_ff1": nrm(ks[22], (DEPTH, D_MODEL, D_FF), D_MODEL ** -0.5),
        "w_ff2": nrm(ks[23], (DEPTH, D_FF, D_MODEL), D_FF ** -0.5),
    }


def reference(x, c, w_ada, b_ada, norm1_g, w_in, q_norm_g, k_norm_g, lam_re, lam_im, log_step,
              b_re, b_im, c_re, c_im, d_skip, w_glu, b_glu, attn_out_g, ssm_out_g, w_out,
              norm2_g, w_ff1, w_ff2):
    for l in range(DEPTH):
        x = hybrid_layer(x, c, w_ada[l], b_ada[l], norm1_g[l], w_in[l], q_norm_g[l], k_norm_g[l],
                         lam_re[l], lam_im[l], log_step[l], b_re[l], b_im[l], c_re[l], c_im[l],
                         d_skip[l], w_glu[l], b_glu[l], attn_out_g[l], ssm_out_g[l], w_out[l],
                         norm2_g[l], w_ff1[l], w_ff2[l])
    return x
```

```cpp
#include <hip/hip_runtime.h>
#include <hip/hip_cooperative_groups.h>
#include <cstdio>
#include <cstdint>
namespace cg = cooperative_groups;

#ifndef PH_MASK
#define PH_MASK 0xFFF
#endif
#ifndef DUP_MASK
#define DUP_MASK 0
#endif
#define NREP(k) ((((DUP_MASK) >> (k)) & 1) ? 2 : 1)
#ifndef ONE_LAUNCH
#define ONE_LAUNCH 1
#endif

#define LAS __attribute__((address_space(3)))
typedef unsigned short bf16_t;
typedef short bf16x8 __attribute__((ext_vector_type(8)));
typedef short s16x4 __attribute__((ext_vector_type(4)));
typedef float f32x4 __attribute__((ext_vector_type(4)));
typedef float f32x2 __attribute__((ext_vector_type(2)));
typedef unsigned u32x4 __attribute__((ext_vector_type(4)));
typedef unsigned u32x2 __attribute__((ext_vector_type(2)));
typedef __bf16 bf16x2_t __attribute__((ext_vector_type(2)));

constexpr int DM = 2048, BATCH = 4, SEQ = 8192, MTOK = BATCH * SEQ;
constexpr int AW = 1024, HD = 128, NH = 8, SW = 1024, NG = 64, GS = 16, NP = 64;
constexpr int INW = 4096, DFF = 8192, NMODC = 6 * DM;
constexpr int LS = 32;
constexpr int NSC = SEQ / LS;
constexpr int RPG = BATCH * NSC;
constexpr int KU = GS * LS;
constexpr int KA = KU + 128;
constexpr int NT = GS * LS;
constexpr int MSSM = NG * RPG;
constexpr float EPS = 1e-6f;
constexpr float QSCALE = 0.08838834764831845f * 1.4426950408889634f;

constexpr size_t MiB = 1u << 20;
constexpr size_t WS_CTL = 0, CTL_BYTES = 1 * MiB;
constexpr size_t WS_MODP = 1 * MiB;
constexpr size_t WS_MOD = 640 * 1024;
constexpr size_t WS_AL = 4 * MiB;
constexpr size_t WS_WIN = 8 * MiB;
constexpr size_t WS_WGLU = 24 * MiB;
constexpr size_t WS_WOUT = 26 * MiB;
constexpr size_t WS_WFF1 = 34 * MiB;
constexpr size_t WS_WFF2 = 66 * MiB;
constexpr size_t WS_TW = 98 * MiB;
constexpr size_t WS_WS = 138 * MiB;
constexpr size_t WS_XN = 160 * MiB;
constexpr size_t WS_ASSM = 288 * MiB;
constexpr size_t WS_SLOC = 368 * MiB;
constexpr size_t WS_QKV = 400 * MiB;
constexpr size_t WS_ATTP = 592 * MiB;
constexpr size_t WS_LSE = 784 * MiB;
constexpr size_t WS_YACT = 788 * MiB;
constexpr size_t WS_SSMO = 852 * MiB;
constexpr size_t WS_ACT = 288 * MiB;
constexpr size_t WS_H2 = 852 * MiB;
constexpr size_t WS_SSQ = 512 * 1024;
constexpr size_t WS_BIAS2 = 3 * MiB + 512 * 1024;
constexpr size_t WS_END = 980 * MiB;
static_assert(WS_TW + (size_t)NG * NT * KA * 2 <= WS_WS && WS_WS + (size_t)NG * 256 * KU * 2 <= WS_XN, "ws map");
static_assert(WS_ASSM + (size_t)MSSM * KA * 2 <= WS_SLOC && WS_SLOC + (size_t)MSSM * 128 * 4 <= WS_QKV, "ws map");
static_assert(WS_ACT + (size_t)MTOK * DFF * 2 <= WS_SSMO, "ws map");

constexpr int LDS_BYTES = 151552;
constexpr int NPH = 12;
constexpr int ATT_NIT = 3 * BATCH * NH * 64;
constexpr int PFX_BLOCKS = 32, ATT_EARLY_PER = 3;
constexpr int ATT_NIT5 = ATT_NIT - (256 - PFX_BLOCKS) * ATT_EARLY_PER;

__device__ __forceinline__ unsigned pk2(float lo, float hi) { f32x2 v = {lo, hi}; bf16x2_t b = __builtin_convertvector(v, bf16x2_t); return __builtin_bit_cast(unsigned, b); }
__device__ __forceinline__ float bflo(unsigned w) { return __uint_as_float(w << 16); }
__device__ __forceinline__ float bfhi(unsigned w) { return __uint_as_float(w & 0xffff0000u); }
__device__ __forceinline__ float wave_sum(float v) {
#pragma unroll
    for (int o = 1; o < 64; o <<= 1) v += __shfl_xor(v, o);
    return v;
}
#define LDS_WAIT() asm volatile("s_waitcnt lgkmcnt(0)" ::: "memory")

namespace pg8 {
#define PG8_LAS __attribute__((address_space(3)))
constexpr int BM = 256, BK = 64, HALF = 128, HTB = HALF * BK * 2, STAGE_BYTES = 8 * HTB, NXCD = 8, WGM = 8;
__host__ __device__ __forceinline__ int lds_byte(int r, int c) { const int st = (r >> 4) * 2 + (c >> 5), rr = r & 15, cc = c & 31, ob = rr * 64 + cc * 2; return st * 1024 + (ob ^ (((ob >> 9) & 1) << 5)); }
__host__ __device__ __forceinline__ void stage_rc(int b, int& R, int& C) { const int st = b / 1024, sb = b % 1024, swz = sb ^ (((sb >> 9) & 1) << 5); R = (st >> 1) * 16 + swz / 64; C = (st & 1) * 32 + (swz % 64) / 2; }
__host__ __device__ __forceinline__ int perm32(int rho) { const int n = rho >> 4, i = rho & 15; return 8 * (i >> 2) + 4 * n + (i & 3); }

struct Unit { int pm, pn; };
struct Gemm { const bf16_t* A; const bf16_t* Bt; int M, N, K, lda, ldb, bgrp; size_t bgstride; };

struct StaticOrder {
    int nM, nN, nwg, G, c;
    __device__ void init(int M, int N, int G_, int c_) { nM = M / BM; nN = N / BM; nwg = nM * nN; G = G_; c = c_; }
    __device__ bool next(int i, Unit& u) const {
        const long L = (long)i * G + c; if (L >= nwg) return false;
        int wgid = (int)L; { const int q = nwg / NXCD, r = nwg % NXCD, xcd = wgid % NXCD, off = wgid / NXCD; wgid = (xcd < r ? xcd * (q + 1) : r * (q + 1) + (xcd - r) * q) + off; }
        const int nig = WGM * nN, gid = wgid / nig, fm = gid * WGM, gsz = (nM - fm) < WGM ? (nM - fm) : WGM;
        u.pm = fm + ((wgid % nig) % gsz); u.pn = (wgid % nig) / gsz; return true;
    }
};

template <class Epi, bool HALFN = false>
__device__ __forceinline__ void gemm_phase(PG8_LAS unsigned char* lds, const Gemm g, const StaticOrder& S, const Epi& E) {
    const int tid = threadIdx.x, wid = __builtin_amdgcn_readfirstlane(tid >> 6), lane = tid & 63, wr = wid >> 2, wc = wid & 3, fr = lane & 15, fq = lane >> 4;
    const int K = g.K, nt = K / BK;
    unsigned voffA[2], voffB[2];
#pragma unroll
    for (int i = 0; i < 2; ++i) { int R, C; stage_rc(tid * 16 + i * 8192, R, C); const int Rb = Epi::PERM ? ((R & ~31) + perm32(R & 31)) : R;
        voffA[i] = (unsigned)(R * g.lda + C) * 2u; voffB[i] = (unsigned)(Rb * g.ldb + C) * 2u; }
    const size_t kstep = (size_t)(BK * 2);
    const size_t hstepA = (size_t)HALF * g.lda * 2, hstepB = (size_t)HALF * g.ldb * 2;
    const size_t tstepA = 2 * hstepA, tstepB = 2 * hstepB;
    const unsigned ldsw = (unsigned)wid * 1024u;
    const int aoff = lds_byte(wr * 64 + fr, fq * 8), boff = lds_byte(wc * 32 + fr, fq * 8);
#define PG8_SA(b, h) (((b) * 2 + (h)) * HTB)
#define PG8_SB(b, h) ((4 + (b) * 2 + (h)) * HTB)
#define PG8_STAGE(bufoff, gbase, voff) do { _Pragma("unroll") for (int _i = 0; _i < 2; ++_i) \
        __builtin_amdgcn_global_load_lds((const unsigned*)((const char*)(gbase) + (voff)[_i]), (PG8_LAS unsigned*)(lds + (bufoff) + ldsw + _i * 8192), 16, 0, 0); } while (0)
#define PG8_LDA(dst, b, h) do { _Pragma("unroll") for (int m = 0; m < 4; ++m) _Pragma("unroll") for (int k = 0; k < 2; ++k) dst[m][k] = *(const PG8_LAS bf16x8*)(lds + PG8_SA(b, h) + aoff + m * 2048 + k * 1024); } while (0)
#define PG8_LDB(dst, b, h) do { _Pragma("unroll") for (int n = 0; n < 2; ++n) _Pragma("unroll") for (int k = 0; k < 2; ++k) dst[n][k] = *(const PG8_LAS bf16x8*)(lds + PG8_SB(b, h) + boff + n * 2048 + k * 1024); } while (0)
#define PG8_MMA(ai, bj, At, Bt) do { __builtin_amdgcn_s_setprio(1); _Pragma("unroll") for (int m = 0; m < 4; ++m) _Pragma("unroll") for (int n = 0; n < 2; ++n) _Pragma("unroll") for (int k = 0; k < 2; ++k) \
        acc[ai][bj][m][n] = __builtin_amdgcn_mfma_f32_16x16x32_bf16(Bt[n][k], At[m][k], acc[ai][bj][m][n], 0, 0, 0); __builtin_amdgcn_s_setprio(0); } while (0)
#define PG8_WAIT_V(n) asm volatile("s_waitcnt vmcnt(" #n ")" ::: "memory")
#define PG8_WAIT_L(n) asm volatile("s_waitcnt lgkmcnt(" #n ")" ::: "memory")
#define PG8_BAR __builtin_amdgcn_s_barrier()
#define PG8_SCHED __builtin_amdgcn_sched_barrier(0)
#define PG8_BBASE(u) ((const char*)g.Bt + (size_t)(u).pn * tstepB + (g.bgrp ? (size_t)((u).pm / g.bgrp) * g.bgstride : (size_t)0))
    Unit cur, nxt; int ui = 0;
    if (!S.next(0, cur)) return;
    f32x4 acc[2][2][4][2];
#pragma unroll
    for (int a = 0; a < 2; ++a)
#pragma unroll
        for (int b = 0; b < 2; ++b)
#pragma unroll
            for (int m = 0; m < 4; ++m)
#pragma unroll
                for (int n = 0; n < 2; ++n) acc[a][b][m][n] = (f32x4){0.f, 0.f, 0.f, 0.f};
    bf16x8 At[4][2], B0[2][2], B1[2][2];
    const char* cA = (const char*)g.A + (size_t)cur.pm * tstepA; const char* cB = PG8_BBASE(cur);
    PG8_STAGE(PG8_SB(0, 0), cB, voffB); PG8_STAGE(PG8_SB(0, 1), cB + hstepB, voffB); PG8_STAGE(PG8_SA(0, 0), cA, voffA); PG8_STAGE(PG8_SA(0, 1), cA + hstepA, voffA);
    if (wr == 1) PG8_BAR;
    PG8_WAIT_V(2); PG8_BAR;
    PG8_STAGE(PG8_SB(1, 0), cB + kstep, voffB); PG8_STAGE(PG8_SA(1, 0), cA + kstep, voffA); PG8_STAGE(PG8_SB(1, 1), cB + hstepB + kstep, voffB);
    PG8_WAIT_V(6); PG8_BAR;
    for (;;) {
        const bool has_next = S.next(ui + 1, nxt);
        const char* nA = has_next ? (const char*)g.A + (size_t)nxt.pm * tstepA : cA; const char* nB = has_next ? PG8_BBASE(nxt) : cB;
        for (int t = 0; t < nt; t += 2) {
            const bool last = (t == nt - 2);
            const char* a1 = cA + (size_t)(t + 1) * kstep;
            const char* a2 = last ? nA : cA + (size_t)(t + 2) * kstep; const char* b2 = last ? nB : cB + (size_t)(t + 2) * kstep;
            const char* a3 = a2 + kstep; const char* b3 = b2 + kstep;
            PG8_LDB(B0, 0, 0); PG8_LDB(B1, 0, 1); PG8_SCHED; PG8_LDA(At, 0, 0); PG8_STAGE(PG8_SA(1, 1), a1 + hstepA, voffA);
            PG8_WAIT_V(8); PG8_WAIT_L(0); PG8_BAR; PG8_MMA(0, 0, At, B0); if constexpr (!HALFN) PG8_MMA(0, 1, At, B1); PG8_BAR; PG8_SCHED;
            PG8_LDA(At, 0, 1); PG8_STAGE(PG8_SB(0, 0), b2, voffB); PG8_STAGE(PG8_SB(0, 1), b2 + hstepB, voffB); PG8_STAGE(PG8_SA(0, 0), a2, voffA);
            PG8_WAIT_V(8); PG8_WAIT_L(0); PG8_BAR; PG8_MMA(1, 0, At, B0); if constexpr (!HALFN) PG8_MMA(1, 1, At, B1); PG8_BAR; PG8_SCHED;
            PG8_LDB(B0, 1, 0); PG8_LDB(B1, 1, 1); PG8_SCHED; PG8_LDA(At, 1, 0); PG8_STAGE(PG8_SA(0, 1), a2 + hstepA, voffA);
            PG8_WAIT_V(8); PG8_WAIT_L(0); PG8_BAR; PG8_MMA(0, 0, At, B0); if constexpr (!HALFN) PG8_MMA(0, 1, At, B1); PG8_BAR; PG8_SCHED;
            PG8_LDA(At, 1, 1); PG8_STAGE(PG8_SB(1, 0), b3, voffB); PG8_STAGE(PG8_SB(1, 1), b3 + hstepB, voffB); PG8_STAGE(PG8_SA(1, 0), a3, voffA);
            PG8_WAIT_V(8); PG8_WAIT_L(0); PG8_BAR; PG8_MMA(1, 0, At, B0); if constexpr (!HALFN) PG8_MMA(1, 1, At, B1); PG8_BAR; PG8_SCHED;
        }
        if (wr == 0) PG8_BAR;
        E(acc, cur, wr, wc, fr, fq);
        if (!has_next) break;
#pragma unroll
        for (int a = 0; a < 2; ++a)
#pragma unroll
            for (int b = 0; b < 2; ++b)
#pragma unroll
                for (int m = 0; m < 4; ++m)
#pragma unroll
                    for (int n = 0; n < 2; ++n) acc[a][b][m][n] = (f32x4){0.f, 0.f, 0.f, 0.f};
        cur = nxt; cA = nA; cB = nB; ++ui;
        if (wr == 1) PG8_BAR;
    }
    PG8_WAIT_V(0);
    PG8_BAR;
#undef PG8_SA
#undef PG8_SB
#undef PG8_STAGE
#undef PG8_LDA
#undef PG8_LDB
#undef PG8_MMA
#undef PG8_WAIT_V
#undef PG8_WAIT_L
#undef PG8_BAR
#undef PG8_SCHED
#undef PG8_BBASE
}

__device__ __forceinline__ u32x4 pack8(const f32x4 v0, const f32x4 v1) { u32x4 w; w.x = pk2(v0[0], v0[1]); w.y = pk2(v0[2], v0[3]); w.z = pk2(v1[0], v1[1]); w.w = pk2(v1[2], v1[3]); return w; }

struct EpiProj {
    static constexpr bool PERM = true;
    bf16_t* QKV; bf16_t* ASSM; const float* qg; const float* kg; PG8_LAS float* red;
    __device__ __forceinline__ void operator()(const f32x4 (&acc)[2][2][4][2], const Unit& u, int wr, int wc, int fr, int fq) const {
        const int row0 = u.pm * BM + wr * 64 + fr;
        if (u.pn < 8) {
#pragma unroll
            for (int ai = 0; ai < 2; ++ai)
#pragma unroll
                for (int m = 0; m < 4; ++m)
#pragma unroll
                    for (int bj = 0; bj < 2; ++bj) { const f32x4 v0 = acc[ai][bj][m][0], v1 = acc[ai][bj][m][1];
                        float ss = (v0[0] * v0[0] + v0[1] * v0[1]) + (v0[2] * v0[2] + v0[3] * v0[3]) + (v1[0] * v1[0] + v1[1] * v1[1]) + (v1[2] * v1[2] + v1[3] * v1[3]);
                        ss += __shfl_xor(ss, 16); ss += __shfl_xor(ss, 32);
                        if (fq == 0) red[((ai * HALF + wr * 64 + m * 16 + fr) * 2 + bj) * 4 + wc] = ss; }
            asm volatile("s_waitcnt lgkmcnt(0)" ::: "memory"); __builtin_amdgcn_s_barrier(); asm volatile("" ::: "memory");
            const float* gp = (u.pn < 4) ? qg : kg; const float gsc = (u.pn < 4) ? QSCALE : 1.0f;
            f32x4 g0 = *(const f32x4*)(gp + wc * 32 + 8 * fq), g1 = *(const f32x4*)(gp + wc * 32 + 8 * fq + 4); g0 = g0 * gsc; g1 = g1 * gsc;
            const int col0 = u.pn * BM + wc * 32 + 8 * fq;
#pragma unroll
            for (int ai = 0; ai < 2; ++ai)
#pragma unroll
                for (int m = 0; m < 4; ++m) { bf16_t* rowp = QKV + (size_t)(row0 + ai * HALF + m * 16) * 3072 + col0;
#pragma unroll
                    for (int bj = 0; bj < 2; ++bj) { const f32x4 pr = *(const PG8_LAS f32x4*)(red + ((ai * HALF + wr * 64 + m * 16 + fr) * 2 + bj) * 4);
                        const float rstd = rsqrtf(((pr[0] + pr[1]) + (pr[2] + pr[3])) * (1.f / HD) + EPS);
                        *(u32x4*)(rowp + bj * HALF) = pack8(acc[ai][bj][m][0] * rstd * g0, acc[ai][bj][m][1] * rstd * g1); } }
        } else if (u.pn < 12) {
            const int col0 = u.pn * BM + wc * 32 + 8 * fq;
#pragma unroll
            for (int ai = 0; ai < 2; ++ai)
#pragma unroll
                for (int m = 0; m < 4; ++m) { bf16_t* rowp = QKV + (size_t)(row0 + ai * HALF + m * 16) * 3072 + col0;
#pragma unroll
                    for (int bj = 0; bj < 2; ++bj) *(u32x4*)(rowp + bj * HALF) = pack8(acc[ai][bj][m][0], acc[ai][bj][m][1]); }
        } else {
#pragma unroll
            for (int ai = 0; ai < 2; ++ai)
#pragma unroll
                for (int m = 0; m < 4; ++m) { const int row = row0 + ai * HALF + m * 16; const int b = row / SEQ, tt = row % SEQ, sc = tt / LS, s = tt % LS;
#pragma unroll
                    for (int bj = 0; bj < 2; ++bj) { const int colu = (u.pn - 12) * BM + bj * HALF + wc * 32 + 8 * fq; const int gg = colu >> 4, j0 = colu & 15;
                        bf16_t* dst = ASSM + ((size_t)gg * RPG + (size_t)b * NSC + sc) * KA + s * 16 + j0;
                        *(u32x4*)dst = pack8(acc[ai][bj][m][0], acc[ai][bj][m][1]); } }
        }
    }
};
struct EpiSloc {
    static constexpr bool PERM = false;
    float* SLOC;
    __device__ __forceinline__ void operator()(const f32x4 (&acc)[2][2][4][2], const Unit& u, int wr, int wc, int fr, int fq) const {
        const int row0 = u.pm * BM + wr * 64 + fr, col0 = wc * 32 + 4 * fq;
#pragma unroll
        for (int ai = 0; ai < 2; ++ai)
#pragma unroll
            for (int m = 0; m < 4; ++m) { float* rowp = SLOC + (size_t)(row0 + ai * HALF + m * 16) * 128 + col0;
#pragma unroll
                for (int n = 0; n < 2; ++n) *(f32x4*)(rowp + n * 16) = acc[ai][0][m][n]; }
    }
};
__device__ __forceinline__ float gelu_tanh(float v) {
    const float z = 0.7978845608028654f * (v + 0.044715f * v * v * v);
    const float e = __expf(2.f * z);
    const float th = 1.f - 2.f / (1.f + e);
    return 0.5f * v * (1.f + th);
}
struct EpiY {
    static constexpr bool PERM = true;
    const bf16_t* ASSM; bf16_t* YACT; const float* dskip;
    __device__ __forceinline__ void operator()(const f32x4 (&acc)[2][2][4][2], const Unit& u, int wr, int wc, int fr, int fq) const {
        const int row0 = u.pm * BM + wr * 64 + fr;
#pragma unroll
        for (int ai = 0; ai < 2; ++ai)
#pragma unroll
            for (int m = 0; m < 4; ++m) { const int R = row0 + ai * HALF + m * 16; const int gg = R / RPG, rem = R % RPG, b = rem / NSC, sc = rem % NSC;
#pragma unroll
                for (int bj = 0; bj < 2; ++bj) { const int c = u.pn * BM + bj * HALF + wc * 32 + 8 * fq; const int t = c >> 4, i0 = c & 15;
                    const u32x4 uw = *(const u32x4*)(ASSM + (size_t)R * KA + c);
                    const f32x4 d0 = *(const f32x4*)(dskip + gg * 16 + i0), d1 = *(const f32x4*)(dskip + gg * 16 + i0 + 4);
                    f32x4 v0 = acc[ai][bj][m][0], v1 = acc[ai][bj][m][1];
                    v0[0] += d0[0] * bflo(uw.x); v0[1] += d0[1] * bfhi(uw.x); v0[2] += d0[2] * bflo(uw.y); v0[3] += d0[3] * bfhi(uw.y);
                    v1[0] += d1[0] * bflo(uw.z); v1[1] += d1[1] * bfhi(uw.z); v1[2] += d1[2] * bflo(uw.w); v1[3] += d1[3] * bfhi(uw.w);
#pragma unroll
                    for (int e = 0; e < 4; ++e) { v0[e] = gelu_tanh(v0[e]); v1[e] = gelu_tanh(v1[e]); }
                    const size_t tok = (size_t)b * SEQ + (size_t)sc * LS + t;
                    *(u32x4*)(YACT + tok * SW + gg * 16 + i0) = pack8(v0, v1); } }
    }
};
struct EpiGlu {
    static constexpr bool PERM = true;
    const bf16_t* YACT; bf16_t* SSMO; const float* bglu;
    __device__ __forceinline__ void operator()(const f32x4 (&acc)[2][2][4][2], const Unit& u, int wr, int wc, int fr, int fq) const {
        const int row0 = u.pm * BM + wr * 64 + fr, col0 = u.pn * BM + wc * 32 + 8 * fq;
#pragma unroll
        for (int ai = 0; ai < 2; ++ai)
#pragma unroll
            for (int m = 0; m < 4; ++m) { const size_t ro = (size_t)(row0 + ai * HALF + m * 16) * SW + col0;
#pragma unroll
                for (int bj = 0; bj < 2; ++bj) { const u32x4 yw = *(const u32x4*)(YACT + ro + bj * HALF);
                    const f32x4 b0 = *(const f32x4*)(bglu + col0 + bj * HALF), b1 = *(const f32x4*)(bglu + col0 + bj * HALF + 4);
                    f32x4 v0 = acc[ai][bj][m][0] + b0, v1 = acc[ai][bj][m][1] + b1;
#pragma unroll
                    for (int e = 0; e < 4; ++e) { v0[e] = 1.f / (1.f + __expf(-v0[e])); v1[e] = 1.f / (1.f + __expf(-v1[e])); }
                    v0[0] *= bflo(yw.x); v0[1] *= bfhi(yw.x); v0[2] *= bflo(yw.y); v0[3] *= bfhi(yw.y);
                    v1[0] *= bflo(yw.z); v1[1] *= bfhi(yw.z); v1[2] *= bflo(yw.w); v1[3] *= bfhi(yw.w);
                    *(u32x4*)(SSMO + ro + bj * HALF) = pack8(v0, v1); } }
    }
};
struct EpiRes {
    static constexpr bool PERM = false;
    const float* base; float* out; const float* gate;
    __device__ __forceinline__ void operator()(const f32x4 (&acc)[2][2][4][2], const Unit& u, int wr, int wc, int fr, int fq) const {
        const int row0 = u.pm * BM + wr * 64 + fr, col0 = u.pn * BM + wc * 32 + 4 * fq;
        const int b = (u.pm * BM) / SEQ;
        f32x4 gv[2][2];
#pragma unroll
        for (int bj = 0; bj < 2; ++bj)
#pragma unroll
            for (int n = 0; n < 2; ++n) gv[bj][n] = *(const f32x4*)(gate + (size_t)b * NMODC + col0 + bj * HALF + n * 16);
#pragma unroll
        for (int ai = 0; ai < 2; ++ai)
#pragma unroll
            for (int m = 0; m < 4; ++m) { const size_t off = (size_t)(row0 + ai * HALF + m * 16) * DM + col0;
#pragma unroll
                for (int bj = 0; bj < 2; ++bj)
#pragma unroll
                    for (int n = 0; n < 2; ++n) { const f32x4 bs = *(const f32x4*)(base + off + bj * HALF + n * 16);
                        *(f32x4*)(out + off + bj * HALF + n * 16) = bs + gv[bj][n] * acc[ai][bj][m][n]; }
                asm volatile("" ::: "memory"); }
    }
};
struct EpiSqRelu {
    static constexpr bool PERM = true;
    bf16_t* O;
    __device__ __forceinline__ void operator()(const f32x4 (&acc)[2][2][4][2], const Unit& u, int wr, int wc, int fr, int fq) const {
        const int row0 = u.pm * BM + wr * 64 + fr, col0 = u.pn * BM + wc * 32 + 8 * fq;
#pragma unroll
        for (int ai = 0; ai < 2; ++ai)
#pragma unroll
            for (int m = 0; m < 4; ++m) { bf16_t* rowp = O + (size_t)(row0 + ai * HALF + m * 16) * DFF + col0;
#pragma unroll
                for (int bj = 0; bj < 2; ++bj) { f32x4 v0 = acc[ai][bj][m][0], v1 = acc[ai][bj][m][1];
#pragma unroll
                    for (int e = 0; e < 4; ++e) { const float a0 = fmaxf(v0[e], 0.f), a1 = fmaxf(v1[e], 0.f); v0[e] = a0 * a0; v1[e] = a1 * a1; }
                    *(u32x4*)(rowp + bj * HALF) = pack8(v0, v1); } }
    }
};

struct EpiResN {
    static constexpr bool PERM = true;
    const float* base; float* out; const float* gate; const float* n2g; const float* sc2; bf16_t* H2; float* SSQ;
    __device__ __forceinline__ void operator()(const f32x4 (&acc)[2][2][4][2], const Unit& u, int wr, int wc, int fr, int fq) const {
        const int row0 = u.pm * BM + wr * 64 + fr, col0 = u.pn * BM + wc * 32 + 8 * fq;
        const int b = (u.pm * BM) / SEQ;
        f32x4 gv[2][2], gn[2][2];
#pragma unroll
        for (int bj = 0; bj < 2; ++bj)
#pragma unroll
            for (int n = 0; n < 2; ++n) { const int c = col0 + bj * HALF + 4 * n; gv[bj][n] = *(const f32x4*)(gate + (size_t)b * NMODC + c);
                gn[bj][n] = *(const f32x4*)(n2g + c) * (*(const f32x4*)(sc2 + (size_t)b * NMODC + c) + 1.0f); }
#pragma unroll
        for (int ai = 0; ai < 2; ++ai)
#pragma unroll
            for (int m = 0; m < 4; ++m) { const int row = row0 + ai * HALF + m * 16; const size_t off = (size_t)row * DM + col0; float ss = 0.f;
#pragma unroll
                for (int bj = 0; bj < 2; ++bj) { f32x4 x1[2];
#pragma unroll
                    for (int n = 0; n < 2; ++n) { const f32x4 bs = *(const f32x4*)(base + off + bj * HALF + 4 * n); x1[n] = bs + gv[bj][n] * acc[ai][bj][m][n];
                        *(f32x4*)(out + off + bj * HALF + 4 * n) = x1[n]; ss += (x1[n][0] * x1[n][0] + x1[n][1] * x1[n][1]) + (x1[n][2] * x1[n][2] + x1[n][3] * x1[n][3]); }
                    *(u32x4*)(H2 + off + bj * HALF) = pack8(x1[0] * gn[bj][0], x1[1] * gn[bj][1]); }
                ss += __shfl_xor(ss, 16); ss += __shfl_xor(ss, 32);
                if (fq == 0) atomicAdd(SSQ + row, ss);
                asm volatile("" ::: "memory"); }
    }
};
struct EpiSqReluN {
    static constexpr bool PERM = true;
    bf16_t* O; const float* SSQ; const float* bias2;
    __device__ __forceinline__ void operator()(const f32x4 (&acc)[2][2][4][2], const Unit& u, int wr, int wc, int fr, int fq) const {
        const int row0 = u.pm * BM + wr * 64 + fr, col0 = u.pn * BM + wc * 32 + 8 * fq;
        const int b = (u.pm * BM) / SEQ;
        f32x4 bv[2][2];
#pragma unroll
        for (int bj = 0; bj < 2; ++bj)
#pragma unroll
            for (int n = 0; n < 2; ++n) bv[bj][n] = *(const f32x4*)(bias2 + (size_t)b * DFF + col0 + bj * HALF + 4 * n);
#pragma unroll
        for (int ai = 0; ai < 2; ++ai)
#pragma unroll
            for (int m = 0; m < 4; ++m) { const int row = row0 + ai * HALF + m * 16; const float rstd = rsqrtf(SSQ[row] * (1.f / DM) + EPS);
                bf16_t* rowp = O + (size_t)row * DFF + col0;
#pragma unroll
                for (int bj = 0; bj < 2; ++bj) { f32x4 v0 = acc[ai][bj][m][0] * rstd + bv[bj][0], v1 = acc[ai][bj][m][1] * rstd + bv[bj][1];
#pragma unroll
                    for (int e = 0; e < 4; ++e) { const float a0 = fmaxf(v0[e], 0.f), a1 = fmaxf(v1[e], 0.f); v0[e] = a0 * a0; v1[e] = a1 * a1; }
                    *(u32x4*)(rowp + bj * HALF) = pack8(v0, v1); } }
    }
};
}

struct Args { const float* in[24]; float* out; unsigned char* ws; int ph_lo, ph_hi; };
enum { I_X = 0, I_C, I_WADA, I_BADA, I_N1G, I_WIN, I_QG, I_KG, I_LRE, I_LIM, I_LSTEP, I_BRE, I_BIM, I_CRE, I_CIM, I_DSKIP, I_WGLU, I_BGLU, I_AOG, I_SOG, I_WOUT, I_N2G, I_WFF1, I_WFF2 };

__device__ __forceinline__ void p0_mod_item(const float* c, const float* w_ada, const float* b_ada, float* MOD, LAS unsigned char* lds, int item, int tid, int wave, int lane) {
    const int cgi = item % 48, ks = item / 48;
    LAS float* sc = (LAS float*)lds; LAS float* red = (LAS float*)(lds + 4096);
    __syncthreads();
    for (int u = tid; u < 1024; u += 512) { const int b = u >> 8, kk = u & 255; const float v = c[b * DM + ks * 256 + kk]; sc[u] = v / (1.f + __expf(-v)); }
    __syncthreads();
    f32x4 acc[4];
#pragma unroll
    for (int b = 0; b < 4; ++b) acc[b] = (f32x4){0.f, 0.f, 0.f, 0.f};
    const float* wp = w_ada + (size_t)(ks * 256 + wave * 32) * NMODC + cgi * 256 + lane * 4;
#pragma unroll 16
    for (int kk = 0; kk < 32; ++kk) {
        const f32x4 w = *(const f32x4*)(wp + (size_t)kk * NMODC);
#pragma unroll
        for (int b = 0; b < 4; ++b) { const float s = sc[b * 256 + wave * 32 + kk]; acc[b] += w * s; }
    }
#pragma unroll
    for (int b = 0; b < 4; ++b) *(LAS f32x4*)(red + (wave * 4 + b) * 256 + lane * 4) = acc[b];
    __syncthreads();
    for (int u = tid; u < 1024; u += 512) { const int b = u >> 8, col = u & 255; float s = 0.f;
#pragma unroll
        for (int w = 0; w < 8; ++w) s += red[(w * 4 + b) * 256 + col];
        if (ks == 0) s += b_ada[cgi * 256 + col];
        atomicAdd(MOD + (size_t)b * NMODC + cgi * 256 + col, s); }
}

__device__ __forceinline__ void p0_transpose_item(const float* W, int K, int N, bf16_t* WT, LAS float* scr, int item, int lane) {
    const int nblk = N / 32, kb = item / nblk, nb = item % nblk, k0 = 64 * kb, n0 = 32 * nb;
    { const int c4 = (lane & 7) * 4, kr = lane >> 3;
      f32x4 v[8];
#pragma unroll
      for (int i = 0; i < 8; ++i) v[i] = *(const f32x4*)(W + (size_t)(k0 + 8 * i + kr) * N + n0 + c4);
#pragma unroll
      for (int i = 0; i < 8; ++i) { LAS float* d = scr + (8 * i + kr) * 33 + c4; d[0] = v[i][0]; d[1] = v[i][1]; d[2] = v[i][2]; d[3] = v[i][3]; } }
    LDS_WAIT(); asm volatile("" ::: "memory");
    const int c = lane & 7;
#pragma unroll
    for (int j = 0; j < 4; ++j) { const int n = (lane >> 3) + 8 * j; const LAS float* s = scr + (8 * c) * 33 + n;
        u32x4 o; o.x = pk2(s[0 * 33], s[1 * 33]); o.y = pk2(s[2 * 33], s[3 * 33]); o.z = pk2(s[4 * 33], s[5 * 33]); o.w = pk2(s[6 * 33], s[7 * 33]);
        *(u32x4*)(WT + (size_t)(n0 + n) * K + k0 + 8 * c) = o; }
    LDS_WAIT(); asm volatile("" ::: "memory");
}

__device__ __forceinline__ void p0_ssm_item(const Args& a, LAS unsigned char* lds, int item, int tid) {
    const int g = item >> 2, q = item & 3;
    unsigned char* ws = a.ws;
    bf16_t* TW = (bf16_t*)(ws + WS_TW); bf16_t* WSm = (bf16_t*)(ws + WS_WS); float* AL = (float*)(ws + WS_AL);
    LAS float* apr = (LAS float*)lds;
    LAS float* api = apr + (LS + 1) * 64;
    LAS float* bbr = api + (LS + 1) * 64;
    LAS float* bbi = bbr + 1024;
    LAS float* ccr = bbi + 1024;
    LAS float* cci = ccr + 1024;
    LAS float* Kt = cci + 1024;
    const float* lam_re = a.in[I_LRE]; const float* lam_im = a.in[I_LIM];
    __syncthreads();
    const float st = expf(a.in[I_LSTEP][g]);
    for (int u = tid; u < (LS + 1) * 64; u += 512) { const int tau = u >> 6, p = u & 63;
        const float lr = lam_re[g * 64 + p] * st, li = lam_im[g * 64 + p] * st;
        const float mag = expf(lr * (float)tau);
        float rev = li * (float)tau * 0.15915494309189535f; rev -= rintf(rev);
        const float ang = rev * 6.283185307179586f;
        apr[u] = mag * cosf(ang); api[u] = mag * sinf(ang); }
    for (int u = tid; u < 1024; u += 512) { const int i = u >> 6, p = u & 63; ccr[u] = a.in[I_CRE][(g * 16 + i) * 64 + p]; cci[u] = a.in[I_CIM][(g * 16 + i) * 64 + p]; }
    __syncthreads();
    for (int u = tid; u < 1024; u += 512) { const int p = u >> 4, j = u & 15;
        const float lr = lam_re[g * 64 + p], li = lam_im[g * 64 + p];
        const float x = apr[64 + p] - 1.f, y = api[64 + p];
        const float den = 1.f / (lr * lr + li * li);
        const float cr_ = (x * lr + y * li) * den, ci_ = (y * lr - x * li) * den;
        const float br = a.in[I_BRE][(g * 64 + p) * 16 + j], bi = a.in[I_BIM][(g * 64 + p) * 16 + j];
        bbr[u] = cr_ * br - ci_ * bi; bbi[u] = cr_ * bi + ci_ * br; }
    __syncthreads();
    for (int u = tid; u < LS * 256; u += 512) { const int tau = u >> 8, i = (u >> 4) & 15, j = u & 15; float s = 0.f;
#pragma unroll 8
        for (int p = 0; p < 64; ++p) { const float ar = apr[tau * 64 + p], ai = api[tau * 64 + p]; const float br = bbr[p * 16 + j], bi = bbi[p * 16 + j];
            const float xr = ar * br - ai * bi, xi = ar * bi + ai * br; s += ccr[i * 64 + p] * xr - cci[i * 64 + p] * xi; }
        Kt[u] = s; }
    __syncthreads();
    constexpr int RQ = NT / 4, PCS = KA / 8, UPC = KU / 8;
    for (int u = tid; u < RQ * PCS; u += 512) {
        const int r = q * RQ + u / PCS, pc = u % PCS; const int t = r >> 4, i = r & 15;
        unsigned w[4];
        if (pc < UPC) { const int s = pc >> 1, j0 = (pc & 1) * 8;
            if (t >= s) {
#pragma unroll
                for (int e2 = 0; e2 < 4; ++e2) w[e2] = pk2(Kt[(t - s) * 256 + i * 16 + j0 + 2 * e2], Kt[(t - s) * 256 + i * 16 + j0 + 2 * e2 + 1]);
            } else { w[0] = w[1] = w[2] = w[3] = 0u; }
        } else { const int pp = (pc - UPC) * 8, p0 = pp & 63, isim = pp >> 6;
#pragma unroll
            for (int e2 = 0; e2 < 4; ++e2) { float v[2];
#pragma unroll
                for (int h = 0; h < 2; ++h) { const int p = p0 + 2 * e2 + h; const float ar = apr[(t + 1) * 64 + p], ai = api[(t + 1) * 64 + p];
                    const float zr = ccr[i * 64 + p] * ar - cci[i * 64 + p] * ai, zi = ccr[i * 64 + p] * ai + cci[i * 64 + p] * ar; v[h] = isim ? -zi : zr; }
                w[e2] = pk2(v[0], v[1]); }
        }
        *(u32x4*)(TW + ((size_t)(g * NT + r)) * KA + pc * 8) = (u32x4){w[0], w[1], w[2], w[3]};
    }
    for (int u = tid; u < 64 * UPC; u += 512) {
        const int pr = q * 64 + u / UPC, pc = u % UPC; const int s = pc >> 1, j0 = (pc & 1) * 8;
        unsigned w[4];
        if (q < 2) { const int p = pr & 63; const float ar = apr[(LS - 1 - s) * 64 + p], ai = api[(LS - 1 - s) * 64 + p];
#pragma unroll
            for (int e2 = 0; e2 < 4; ++e2) { float v[2];
#pragma unroll
                for (int h = 0; h < 2; ++h) { const int j = j0 + 2 * e2 + h; const float br = bbr[p * 16 + j], bi = bbi[p * 16 + j];
                    const float zr = ar * br - ai * bi, zi = ar * bi + ai * br; v[h] = (q == 0) ? zr : zi; }
                w[e2] = pk2(v[0], v[1]); }
        } else { w[0] = w[1] = w[2] = w[3] = 0u; }
        *(u32x4*)(WSm + ((size_t)(g * 256 + pr)) * KU + pc * 8) = (u32x4){w[0], w[1], w[2], w[3]};
    }
    if (q == 0 && tid < 64) { AL[(g * 64 + tid) * 2] = apr[LS * 64 + tid]; AL[(g * 64 + tid) * 2 + 1] = api[LS * 64 + tid]; }
}

__device__ __forceinline__ void norm_mod_phase(const float* src, bf16_t* dst, const float* gvec, const float* shp, const float* scp, int npart, const float* bias_sh, const float* bias_sc, int gw, int lane) {
    const int b = gw >> 9, r0 = gw & 511;
    f32x4 gs[8], sh[8];
#pragma unroll
    for (int j = 0; j < 8; ++j) { const int col = 4 * (j * 64 + lane);
        sh[j] = bias_sh ? *(const f32x4*)(bias_sh + col) : (f32x4){0.f, 0.f, 0.f, 0.f};
        gs[j] = bias_sc ? *(const f32x4*)(bias_sc + col) : (f32x4){0.f, 0.f, 0.f, 0.f}; }
#pragma unroll 1
    for (int s = 0; s < npart; ++s) {
#pragma unroll
        for (int j = 0; j < 8; ++j) { const int col = 4 * (j * 64 + lane);
            sh[j] += *(const f32x4*)(shp + (size_t)s * 4 * NMODC + (size_t)b * NMODC + col); gs[j] += *(const f32x4*)(scp + (size_t)s * 4 * NMODC + (size_t)b * NMODC + col); }
        asm volatile("" ::: "memory");
    }
#pragma unroll
    for (int j = 0; j < 8; ++j) { const int col = 4 * (j * 64 + lane); const f32x4 gvv = *(const f32x4*)(gvec + col); gs[j] = gvv * (gs[j] + 1.0f); }
    for (int k = 0; k < 16; k += 2) {
        const size_t row = (size_t)b * SEQ + r0 + 512 * k;
        const f32x4* xr = (const f32x4*)(src + row * DM) + lane; const f32x4* xr1 = xr + (size_t)512 * DM / 4;
        f32x4 v[8], v1[8]; float ss = 0.f, ss1 = 0.f;
#pragma unroll
        for (int j = 0; j < 8; ++j) { v[j] = xr[64 * j]; v1[j] = xr1[64 * j]; }
#pragma unroll
        for (int j = 0; j < 8; ++j) { ss += (v[j][0] * v[j][0] + v[j][1] * v[j][1]) + (v[j][2] * v[j][2] + v[j][3] * v[j][3]); ss1 += (v1[j][0] * v1[j][0] + v1[j][1] * v1[j][1]) + (v1[j][2] * v1[j][2] + v1[j][3] * v1[j][3]); }
        const float rstd = rsqrtf(wave_sum(ss) * (1.f / DM) + EPS), rstd1 = rsqrtf(wave_sum(ss1) * (1.f / DM) + EPS);
        u32x2* o8 = (u32x2*)(dst + row * DM) + lane; u32x2* o81 = o8 + (size_t)512 * DM / 4;
#pragma unroll
        for (int j = 0; j < 8; ++j) { const f32x4 o = v[j] * rstd * gs[j] + sh[j]; o8[64 * j] = (u32x2){pk2(o[0], o[1]), pk2(o[2], o[3])};
            const f32x4 o1 = v1[j] * rstd1 * gs[j] + sh[j]; o81[64 * j] = (u32x2){pk2(o1[0], o1[1]), pk2(o1[2], o1[3])}; }
    }
}

__device__ __forceinline__ s16x4 vtr(const LAS unsigned char* p) { return __builtin_bit_cast(s16x4, __builtin_amdgcn_ds_read_tr16_b64_v4i16((LAS s16x4*)p)); }
constexpr int AROW = 288, AVOFF = 256 * AROW;
__device__ __forceinline__ void attn_item(const bf16_t* QKV, bf16_t* ATTP, float* LSE, LAS unsigned char* lds, int it, int tid, int wave, int lane) {
    const int rj = it & 63, h = (it >> 6) & 7, b = (it >> 9) & 3, pi = it >> 11;
    const int dsh = 2 * pi, nbsh = 6 - dsh;
    const int r = rj >> nbsh, j = rj & ((1 << nbsh) - 1);
    const int fr = lane & 15, fq = lane >> 4;
    const size_t tokbase = (size_t)b * SEQ;
    __syncthreads();
    {
        u32x4 kv[8], vv[8];
#pragma unroll
        for (int i = 0; i < 8; ++i) { const int piece = tid + 512 * i, row = piece >> 4, pc = piece & 15; const int idx = 128 * (j - 1) + row;
            const size_t tok = tokbase + ((size_t)(idx >= 0 ? idx : 0) << dsh) + r; const bf16_t* src = QKV + tok * 3072 + 1024 + h * 128 + pc * 8;
            kv[i] = *(const u32x4*)src; vv[i] = *(const u32x4*)(src + 1024); }
#pragma unroll
        for (int i = 0; i < 8; ++i) { const int piece = tid + 512 * i, row = piece >> 4, pc = piece & 15;
            *(LAS u32x4*)(lds + row * AROW + pc * 16) = kv[i]; *(LAS u32x4*)(lds + AVOFF + row * AROW + pc * 16) = vv[i]; }
    }
    const int qi = 16 * wave + fr; const size_t qtok = tokbase + ((size_t)(128 * j + qi) << dsh) + r;
    bf16x8 qf[4];
    { const bf16_t* qp = QKV + qtok * 3072 + h * 128 + 8 * fq;
#pragma unroll
      for (int ks = 0; ks < 4; ++ks) qf[ks] = *(const bf16x8*)(qp + 32 * ks); }
    __syncthreads();
    const float slope2 = exp2f(-(float)(h + 1)) * (float)(1 << dsh) * 1.4426950408889634f;
    const float c0 = slope2 * ((float)(4 * fq - fr) - 128.f);
    f32x4 sacc[9];
#pragma unroll
    for (int kbi = 0; kbi < 9; ++kbi) { f32x4 acc;
#pragma unroll
        for (int i = 0; i < 4; ++i) acc[i] = fmaf(slope2, (float)(16 * kbi + i), c0);
        const LAS unsigned char* kp = lds + (16 * (wave + kbi) + fr) * AROW + fq * 16;
#pragma unroll
        for (int ks = 0; ks < 4; ++ks) { const bf16x8 kf = *(const LAS bf16x8*)(kp + ks * 64); acc = __builtin_amdgcn_mfma_f32_16x16x32_bf16(kf, qf[ks], acc, 0, 0, 0); }
        sacc[kbi] = acc; }
    const int rel0 = 4 * fq - fr;
#pragma unroll
    for (int i = 0; i < 4; ++i) { if (rel0 + i < 0) sacc[0][i] = -INFINITY; if (rel0 + i > 0) sacc[8][i] = -INFINITY; }
    if (j == 0) {
#pragma unroll
        for (int kbi = 0; kbi < 8; ++kbi) if (wave + kbi < 8) sacc[kbi] = (f32x4){-INFINITY, -INFINITY, -INFINITY, -INFINITY};
    }
    float mx = -INFINITY;
#pragma unroll
    for (int kbi = 0; kbi < 9; ++kbi)
#pragma unroll
        for (int i = 0; i < 4; ++i) mx = fmaxf(mx, sacc[kbi][i]);
    mx = fmaxf(mx, __shfl_xor(mx, 16)); mx = fmaxf(mx, __shfl_xor(mx, 32));
    float sum = 0.f;
#pragma unroll
    for (int kbi = 0; kbi < 9; ++kbi)
#pragma unroll
        for (int i = 0; i < 4; ++i) { const float p = __builtin_amdgcn_exp2f(sacc[kbi][i] - mx); sacc[kbi][i] = p; sum += p; }
    sum += __shfl_xor(sum, 16); sum += __shfl_xor(sum, 32);
    bf16x8 pf[5];
#pragma unroll
    for (int s = 0; s < 5; ++s) { const f32x4 pa = sacc[2 * s]; const f32x4 pb = (2 * s + 1 < 9) ? sacc[(2 * s + 1 < 9) ? 2 * s + 1 : 0] : (f32x4){0.f, 0.f, 0.f, 0.f};
        const u32x4 w = (u32x4){pk2(pa[0], pa[1]), pk2(pa[2], pa[3]), pk2(pb[0], pb[1]), pk2(pb[2], pb[3])}; pf[s] = __builtin_bit_cast(bf16x8, w); }
    f32x4 o[8];
#pragma unroll
    for (int eb = 0; eb < 8; ++eb) o[eb] = (f32x4){0.f, 0.f, 0.f, 0.f};
    const LAS unsigned char* vb = lds + AVOFF + (4 * fq + (fr >> 2)) * AROW + (4 * (fr & 3)) * 2;
#pragma unroll
    for (int s = 0; s < 5; ++s) { const int kbA = wave + 2 * s, kbB = (s < 4) ? kbA + 1 : kbA;
#pragma unroll
        for (int eb = 0; eb < 8; ++eb) { const s16x4 lo = vtr(vb + kbA * 16 * AROW + eb * 32), hi = vtr(vb + kbB * 16 * AROW + eb * 32);
            const bf16x8 vf = (bf16x8){lo[0], lo[1], lo[2], lo[3], hi[0], hi[1], hi[2], hi[3]};
            o[eb] = __builtin_amdgcn_mfma_f32_16x16x32_bf16(vf, pf[s], o[eb], 0, 0, 0); } }
    const float inv = 1.f / sum;
    bf16_t* op = ATTP + ((size_t)pi * MTOK + qtok) * AW + h * 128 + 4 * fq;
#pragma unroll
    for (int eb = 0; eb < 8; ++eb) *(u32x2*)(op + 16 * eb) = (u32x2){pk2(o[eb][0] * inv, o[eb][1] * inv), pk2(o[eb][2] * inv, o[eb][3] * inv)};
    if (fq == 0) LSE[((size_t)pi * MTOK + qtok) * 8 + h] = (mx + log2f(sum)) * 0.6931471805599453f;
}

#define XB_TMO      128
#define XB_XCNT(j)  (256  + 64 * (j))
#define XB_XSUB(j)  (1280 + 64 * (j))
#define XB_XGEN(j)  (2304 + 64 * (j))
#define XB_TOP      3328
#define XB_TOPGEN   3392
#define XCD_BAR_WORDS 3456
#define XB_SPIN_CAP (1u << 22)
__device__ __forceinline__ unsigned xb_ld(unsigned* p)              { return __hip_atomic_load(p, __ATOMIC_RELAXED, __HIP_MEMORY_SCOPE_AGENT); }
__device__ __forceinline__ unsigned xb_add(unsigned* p, unsigned v) { return __hip_atomic_fetch_add(p, v, __ATOMIC_RELAXED, __HIP_MEMORY_SCOPE_AGENT); }
__device__ __forceinline__ unsigned xb_xcc_id() { return (unsigned)__builtin_amdgcn_s_getreg((3 << 11) | 20) & 0xFu; }
#define XB_SPIN(cond, bar) do { unsigned _sp = 0; while (cond) { __builtin_amdgcn_s_sleep(1); \
    if ((++_sp & 255u) == 0u) { if (xb_ld(&(bar)[XB_TMO])) break; if (_sp > XB_SPIN_CAP) { atomicAdd(&(bar)[XB_TMO], 1u); break; } } } } while (0)
struct XcdBarrier { unsigned* bar; unsigned x; volatile LAS unsigned* st; };
__device__ __forceinline__ XcdBarrier xcd_barrier_post(unsigned* bar, volatile LAS unsigned* st) {
    XcdBarrier b; b.bar = bar; b.x = xb_xcc_id(); b.st = st;
    if (threadIdx.x == 0) (void)xb_add(&bar[XB_XCNT(b.x)], 1u);
    return b;
}
__device__ __forceinline__ void xcd_barrier_complete(unsigned* bar, unsigned x, unsigned& nloc, unsigned& nx) {
    const unsigned G = gridDim.x * gridDim.y * gridDim.z;
    unsigned sum, cnt, mine, sp = 0u;
    for (;;) {
        sum = 0u; cnt = 0u; mine = 0u;
#pragma unroll
        for (unsigned j = 0; j < 16; ++j) { const unsigned c = xb_ld(&bar[XB_XCNT(j)]); sum += c; cnt += (c > 0u) ? 1u : 0u; mine = (j == x) ? c : mine; }
        if (sum == G) break;
        __builtin_amdgcn_s_sleep(1);
        if ((++sp & 255u) == 0u) { if (xb_ld(&bar[XB_TMO])) break; if (sp > XB_SPIN_CAP) { atomicAdd(&bar[XB_TMO], 1u); break; } }
    }
    nloc = mine > 0u ? mine : 1u; nx = cnt > 0u ? cnt : 1u;
}
__device__ __forceinline__ void xcd_barrier(const XcdBarrier& b) {
    asm volatile("s_waitcnt vmcnt(0)" ::: "memory");
    __syncthreads();
    if (threadIdx.x == 0) {
        unsigned* bar = b.bar;
        __builtin_amdgcn_s_waitcnt(0);
        unsigned nloc = b.st[0], nx = b.st[1];
        if (nloc == 0u) { xcd_barrier_complete(bar, b.x, nloc, nx); b.st[0] = nloc; b.st[1] = nx; }
        const unsigned old = xb_add(&bar[XB_XSUB(b.x)], 1u);
        const unsigned gen = old / nloc;
        if (old + 1u == (gen + 1u) * nloc) {
            __builtin_amdgcn_fence(__ATOMIC_RELEASE, "agent");
            asm volatile("s_waitcnt vmcnt(0)" ::: "memory");
            const unsigned og = xb_add(&bar[XB_TOP], 1u);
            const unsigned tg = og / nx;
            if (og + 1u == (tg + 1u) * nx) xb_add(&bar[XB_TOPGEN], 1u);
            else XB_SPIN(xb_ld(&bar[XB_TOPGEN]) == tg, bar);
            __builtin_amdgcn_fence(__ATOMIC_ACQUIRE, "agent");
            xb_add(&bar[XB_XGEN(b.x)], 1u);
            asm volatile("s_waitcnt vmcnt(0)" ::: "memory");
        } else {
            XB_SPIN(xb_ld(&bar[XB_XGEN(b.x)]) == gen, bar);
            __builtin_amdgcn_fence(__ATOMIC_ACQUIRE, "agent");
            asm volatile("s_waitcnt vmcnt(0)" ::: "memory");
        }
    }
    __syncthreads();
}

__global__ void __launch_bounds__(512, 2) fwd_kernel(Args a) {
    extern __shared__ __attribute__((aligned(16))) unsigned char smem[];
    LAS unsigned char* lds = (LAS unsigned char*)smem;
    const int tid = threadIdx.x, lane = tid & 63, wave = __builtin_amdgcn_readfirstlane(tid >> 6);
    const int G = gridDim.x, bid = blockIdx.x;
    const int gw = bid * 8 + wave, NGW = G * 8;
    const int vbid = (G % 8 == 0) ? (bid % 8) * (G / 8) + bid / 8 : bid;
    unsigned char* ws = a.ws;
    float* MODP = (float*)(ws + WS_MODP); float* MOD = (float*)(ws + WS_MOD); float* AL = (float*)(ws + WS_AL);
    bf16_t* WIN = (bf16_t*)(ws + WS_WIN); bf16_t* WGLU = (bf16_t*)(ws + WS_WGLU); bf16_t* WOUT = (bf16_t*)(ws + WS_WOUT);
    bf16_t* WFF1 = (bf16_t*)(ws + WS_WFF1); bf16_t* WFF2 = (bf16_t*)(ws + WS_WFF2);
    bf16_t* TW = (bf16_t*)(ws + WS_TW); bf16_t* WSm = (bf16_t*)(ws + WS_WS);
    bf16_t* XN = (bf16_t*)(ws + WS_XN); bf16_t* ASSM = (bf16_t*)(ws + WS_ASSM); float* SLOC = (float*)(ws + WS_SLOC);
    bf16_t* QKV = (bf16_t*)(ws + WS_QKV); bf16_t* ATTP = (bf16_t*)(ws + WS_ATTP); float* LSE = (float*)(ws + WS_LSE);
    bf16_t* YACT = (bf16_t*)(ws + WS_YACT); bf16_t* SSMO = (bf16_t*)(ws + WS_SSMO); bf16_t* ACT = (bf16_t*)(ws + WS_ACT);
    const int lo = a.ph_lo, hi = a.ph_hi;
#define IN(k) (((PH_MASK >> (k)) & 1) && lo <= (k) && (k) < hi)
#if ONE_LAUNCH
    cg::grid_group grid = cg::this_grid();
    volatile LAS unsigned* xst = (volatile LAS unsigned*)(lds + LDS_BYTES - 4096);
    if (tid == 0) { xst[0] = 0u; xst[1] = 0u; }
    __syncthreads();
    const XcdBarrier xbar = xcd_barrier_post((unsigned*)(ws + WS_CTL) + 4096, xst);
    if (a.ph_hi > 1000) { __threadfence(); grid.sync(); }
#define SEAM(k) do { if (IN(k) && IN((k) + 1)) xcd_barrier(xbar); } while (0)
#else
#define SEAM(k) do { } while (0)
#endif

    if (IN(0)) for (int rep = 0; rep < NREP(0); ++rep) {
        for (int it = bid; it < 384; it += G) p0_mod_item(a.in[I_C], a.in[I_WADA], a.in[I_BADA], MOD, lds, it, tid, wave, lane);
        for (int it = bid; it < 256; it += G) p0_ssm_item(a, lds, it, tid);
        __syncthreads();
        LAS float* scr = (LAS float*)(lds + wave * 16384);
        constexpr int T_IN = (DM / 64) * (INW / 32), T_GLU = (SW / 64) * (SW / 32), T_OUT = (DM / 64) * (DM / 32), T_FF1 = (DM / 64) * (DFF / 32), T_FF2 = (DFF / 64) * (DM / 32);
        for (int it = gw; it < T_IN + T_GLU + T_OUT + T_FF1 + T_FF2; it += NGW) {
            int r = it;
            if (r < T_IN) { p0_transpose_item(a.in[I_WIN], DM, INW, WIN, scr, r, lane); continue; } r -= T_IN;
            if (r < T_GLU) { p0_transpose_item(a.in[I_WGLU], SW, SW, WGLU, scr, r, lane); continue; } r -= T_GLU;
            if (r < T_OUT) { p0_transpose_item(a.in[I_WOUT], DM, DM, WOUT, scr, r, lane); continue; } r -= T_OUT;
            if (r < T_FF1) { p0_transpose_item(a.in[I_WFF1], DM, DFF, WFF1, scr, r, lane); continue; } r -= T_FF1;
            p0_transpose_item(a.in[I_WFF2], DFF, DM, WFF2, scr, r, lane);
        }
    }
    SEAM(0);
    if (IN(1)) for (int rep = 0; rep < NREP(1); ++rep) {
        norm_mod_phase(a.in[I_X], XN, a.in[I_N1G], MOD + 0, MOD + DM, 1, nullptr, nullptr, gw, lane);
    }
    SEAM(1);
    if (IN(2)) for (int rep = 0; rep < NREP(2); ++rep) {
        pg8::Gemm g{XN, WIN, MTOK, INW, DM, DM, DM, 0, 0}; pg8::StaticOrder S; S.init(MTOK, INW, G, bid);
        pg8::EpiProj E{QKV, ASSM, a.in[I_QG], a.in[I_KG], (LAS float*)(lds + pg8::STAGE_BYTES)};
        pg8::gemm_phase<pg8::EpiProj>(lds, g, S, E);
    }
    SEAM(2);
    if (IN(3)) {
        pg8::Gemm g{ASSM, WSm, MSSM, 256, KU, KA, KU, RPG / 256, (size_t)256 * KU * 2}; pg8::StaticOrder S; S.init(MSSM, 256, G, bid);
        pg8::EpiSloc E{SLOC};
        pg8::gemm_phase<pg8::EpiSloc, true>(lds, g, S, E);
    }
    SEAM(3);
    if (IN(4)) {
        if (bid >= PFX_BLOCKS) {
            for (int k = 0; k < ATT_EARLY_PER; ++k) { const int it = ATT_NIT5 + (bid - PFX_BLOCKS) + (G - PFX_BLOCKS) * k; if (it < ATT_NIT) attn_item(QKV, ATTP, LSE, lds, it, tid, wave, lane); }
            __syncthreads();
        } else for (int it = bid * 8 + wave; it < BATCH * NG; it += PFX_BLOCKS * 8) {
            const int b = it >> 6, g = it & 63; const int p = lane;
            const float alr = AL[(g * 64 + p) * 2], ali = AL[(g * 64 + p) * 2 + 1];
            float hr = 0.f, hi_ = 0.f;
            const size_t R0 = (size_t)g * RPG + (size_t)b * NSC;
            for (int sc0 = 0; sc0 < NSC; sc0 += 32) {
                float sr[32], si[32];
#pragma unroll
                for (int k = 0; k < 32; ++k) { sr[k] = SLOC[(R0 + sc0 + k) * 128 + p]; si[k] = SLOC[(R0 + sc0 + k) * 128 + 64 + p]; }
#pragma unroll
                for (int k = 0; k < 32; ++k) { bf16_t* dst = ASSM + (R0 + sc0 + k) * KA + KU + p;
                    dst[0] = (bf16_t)(pk2(hr, 0.f) & 0xffffu); dst[64] = (bf16_t)(pk2(hi_, 0.f) & 0xffffu);
                    const float nr = alr * hr - ali * hi_ + sr[k], ni = alr * hi_ + ali * hr + si[k]; hr = nr; hi_ = ni; }
            }
        }
    }
    SEAM(4);
    if (IN(5)) {
        for (int rep = 0; rep < NREP(12); ++rep) {
            pg8::Gemm g{ASSM, TW, MSSM, NT, KA, KA, KA, RPG / 256, (size_t)NT * KA * 2}; pg8::StaticOrder S; S.init(MSSM, NT, G, bid);
            pg8::EpiY E{ASSM, YACT, a.in[I_DSKIP]};
            pg8::gemm_phase<pg8::EpiY>(lds, g, S, E);
        }
        for (int rep = 0; rep < NREP(5); ++rep)
        for (int it = vbid; it < ATT_NIT5; it += G) attn_item(QKV, ATTP, LSE, lds, it, tid, wave, lane);
        __syncthreads();
    }
    SEAM(5);
    if (IN(6)) {
        pg8::Gemm g{YACT, WGLU, MTOK, SW, SW, SW, SW, 0, 0}; pg8::StaticOrder S; S.init(MTOK, SW, G, bid);
        pg8::EpiGlu E{YACT, SSMO, a.in[I_BGLU]};
        pg8::gemm_phase<pg8::EpiGlu>(lds, g, S, E);
    }
    SEAM(6);
    if (IN(7)) for (int rep = 0; rep < NREP(7); ++rep) {
        {
            float* BIAS2 = (float*)(ws + WS_BIAS2);
            u32x4 w[4][4];
#pragma unroll
            for (int c = 0; c < 4; ++c) { const u32x4* wr_ = (const u32x4*)(WFF1 + (size_t)(gw + NGW * c) * DM) + lane;
#pragma unroll
                for (int j = 0; j < 4; ++j) w[c][j] = (gw + NGW * c < DFF) ? wr_[64 * j] : (u32x4){0u, 0u, 0u, 0u}; }
#pragma unroll 1
            for (int b = 0; b < 4; ++b) {
                f32x4 s0[4], s1[4];
#pragma unroll
                for (int j = 0; j < 4; ++j) { const int k0 = (j * 64 + lane) * 8; s0[j] = *(const f32x4*)(MOD + (size_t)b * NMODC + 3 * DM + k0); s1[j] = *(const f32x4*)(MOD + (size_t)b * NMODC + 3 * DM + k0 + 4); }
                float acc[4];
#pragma unroll
                for (int c = 0; c < 4; ++c) { float a_ = 0.f;
#pragma unroll
                    for (int j = 0; j < 4; ++j) a_ += s0[j][0] * bflo(w[c][j].x) + s0[j][1] * bfhi(w[c][j].x) + s0[j][2] * bflo(w[c][j].y) + s0[j][3] * bfhi(w[c][j].y) + s1[j][0] * bflo(w[c][j].z) + s1[j][1] * bfhi(w[c][j].z) + s1[j][2] * bflo(w[c][j].w) + s1[j][3] * bfhi(w[c][j].w);
                    acc[c] = wave_sum(a_); }
                if (lane == 0) {
#pragma unroll
                    for (int c = 0; c < 4; ++c) if (gw + NGW * c < DFF) BIAS2[(size_t)b * DFF + gw + NGW * c] = acc[c]; }
            }
        }
        const float* aog = a.in[I_AOG]; const float* sog = a.in[I_SOG];
        for (int m = gw; m < MTOK; m += NGW) {
            float av[2][8], sv[2][8]; float assq = 0.f, sssq = 0.f;
#pragma unroll
            for (int i = 0; i < 2; ++i) { const int e0 = (i * 64 + lane) * 8, hh = e0 >> 7;
                const float l0 = LSE[((size_t)0 * MTOK + m) * 8 + hh], l1 = LSE[((size_t)1 * MTOK + m) * 8 + hh], l2 = LSE[((size_t)2 * MTOK + m) * 8 + hh];
                const float ml = fmaxf(l0, fmaxf(l1, l2)); float w0 = __expf(l0 - ml), w1 = __expf(l1 - ml), w2 = __expf(l2 - ml); const float iw = 1.f / (w0 + w1 + w2); w0 *= iw; w1 *= iw; w2 *= iw;
                const u32x4 x0 = *(const u32x4*)(ATTP + ((size_t)0 * MTOK + m) * AW + e0), x1 = *(const u32x4*)(ATTP + ((size_t)1 * MTOK + m) * AW + e0), x2 = *(const u32x4*)(ATTP + ((size_t)2 * MTOK + m) * AW + e0);
                av[i][0] = w0 * bflo(x0.x) + w1 * bflo(x1.x) + w2 * bflo(x2.x); av[i][1] = w0 * bfhi(x0.x) + w1 * bfhi(x1.x) + w2 * bfhi(x2.x);
                av[i][2] = w0 * bflo(x0.y) + w1 * bflo(x1.y) + w2 * bflo(x2.y); av[i][3] = w0 * bfhi(x0.y) + w1 * bfhi(x1.y) + w2 * bfhi(x2.y);
                av[i][4] = w0 * bflo(x0.z) + w1 * bflo(x1.z) + w2 * bflo(x2.z); av[i][5] = w0 * bfhi(x0.z) + w1 * bfhi(x1.z) + w2 * bfhi(x2.z);
                av[i][6] = w0 * bflo(x0.w) + w1 * bflo(x1.w) + w2 * bflo(x2.w); av[i][7] = w0 * bfhi(x0.w) + w1 * bfhi(x1.w) + w2 * bfhi(x2.w);
                const u32x4 y = *(const u32x4*)(SSMO + (size_t)m * SW + e0);
                sv[i][0] = bflo(y.x); sv[i][1] = bfhi(y.x); sv[i][2] = bflo(y.y); sv[i][3] = bfhi(y.y); sv[i][4] = bflo(y.z); sv[i][5] = bfhi(y.z); sv[i][6] = bflo(y.w); sv[i][7] = bfhi(y.w);
#pragma unroll
                for (int e = 0; e < 8; ++e) { assq += av[i][e] * av[i][e]; sssq += sv[i][e] * sv[i][e]; } }
            const float ra = rsqrtf(wave_sum(assq) * (1.f / AW) + EPS), rs = rsqrtf(wave_sum(sssq) * (1.f / SW) + EPS);
#pragma unroll
            for (int i = 0; i < 2; ++i) { const int e0 = (i * 64 + lane) * 8;
                const f32x4 ga0 = *(const f32x4*)(aog + e0), ga1 = *(const f32x4*)(aog + e0 + 4), gs0 = *(const f32x4*)(sog + e0), gs1 = *(const f32x4*)(sog + e0 + 4);
                u32x4 oa, os;
                oa.x = pk2(av[i][0] * ra * ga0[0], av[i][1] * ra * ga0[1]); oa.y = pk2(av[i][2] * ra * ga0[2], av[i][3] * ra * ga0[3]); oa.z = pk2(av[i][4] * ra * ga1[0], av[i][5] * ra * ga1[1]); oa.w = pk2(av[i][6] * ra * ga1[2], av[i][7] * ra * ga1[3]);
                os.x = pk2(sv[i][0] * rs * gs0[0], sv[i][1] * rs * gs0[1]); os.y = pk2(sv[i][2] * rs * gs0[2], sv[i][3] * rs * gs0[3]); os.z = pk2(sv[i][4] * rs * gs1[0], sv[i][5] * rs * gs1[1]); os.w = pk2(sv[i][6] * rs * gs1[2], sv[i][7] * rs * gs1[3]);
                *(u32x4*)(XN + (size_t)m * DM + e0) = oa; *(u32x4*)(XN + (size_t)m * DM + AW + e0) = os; }
        }
    }
    SEAM(7);
    if (IN(8)) {
        pg8::Gemm g{XN, WOUT, MTOK, DM, DM, DM, DM, 0, 0}; pg8::StaticOrder S; S.init(MTOK, DM, G, bid);
        pg8::EpiResN E{a.in[I_X], a.out, MOD + 2 * DM, a.in[I_N2G], MOD + 4 * DM, (bf16_t*)(ws + WS_H2), (float*)(ws + WS_SSQ)};
        pg8::gemm_phase<pg8::EpiResN>(lds, g, S, E);
    }
    SEAM(8);
    if (IN(10)) for (int rep = 0; rep < NREP(10); ++rep) {
        pg8::Gemm g{(const bf16_t*)(ws + WS_H2), WFF1, MTOK, DFF, DM, DM, DM, 0, 0}; pg8::StaticOrder S; S.init(MTOK, DFF, G, bid);
        pg8::EpiSqReluN E{ACT, (const float*)(ws + WS_SSQ), (const float*)(ws + WS_BIAS2)};
        pg8::gemm_phase<pg8::EpiSqReluN>(lds, g, S, E);
    }
    SEAM(10);
    if (IN(11)) {
        pg8::Gemm g{ACT, WFF2, MTOK, DM, DFF, DFF, DFF, 0, 0}; pg8::StaticOrder S; S.init(MTOK, DM, G, bid);
        pg8::EpiRes E{a.out, a.out, MOD + 5 * DM};
        pg8::gemm_phase<pg8::EpiRes>(lds, g, S, E);
    }
#undef IN
#undef SEAM
}

extern "C" void kernel_launch(void* const* d_in, const int* in_sizes, int n_in, void* d_out, int out_size, void* d_ws, size_t ws_size, hipStream_t stream) {
    static int inited = 0;
    if (!inited) {
        if (n_in != 24 || ws_size < WS_END) { fprintf(stderr, "kernel_launch: unexpected inputs (n_in %d, ws %zu)\n", n_in, ws_size); inited = -1; return; }
        if (hipFuncSetAttribute((const void*)fwd_kernel, hipFuncAttributeMaxDynamicSharedMemorySize, LDS_BYTES) != hipSuccess) { fprintf(stderr, "kernel_launch: hipFuncSetAttribute failed\n"); inited = -1; return; }
        inited = 1;
    }
    if (inited < 0) return;
    (void)hipMemsetAsync((char*)d_ws + WS_CTL, 0, CTL_BYTES, stream);
    Args a{};
    for (int i = 0; i < 24; ++i) a.in[i] = (const float*)d_in[i];
    a.out = (float*)d_out; a.ws = (unsigned char*)d_ws;
    const int grid = 256;
#if ONE_LAUNCH
    a.ph_lo = 0; a.ph_hi = NPH;
    void* args[] = {&a};
    hipError_t e = hipLaunchCooperativeKernel((const void*)fwd_kernel, dim3(grid), dim3(512), args, LDS_BYTES, stream);
    if (e != hipSuccess) fprintf(stderr, "cooperative launch failed: %s\n", hipGetErrorString(e));
#else
    for (int ph = 0; ph < NPH; ++ph) { a.ph_lo = ph; a.ph_hi = ph + 1; hipLaunchKernelGGL(fwd_kernel, dim3(grid), dim3(512), LDS_BYTES, stream, a); }
#endif
}
```

```cpp
#include <hip/hip_runtime.h>
#include <hip/hip_cooperative_groups.h>
#include <cstdio>
#include <cstdint>
namespace cg = cooperative_groups;

#ifndef PH_MASK
#define PH_MASK 0xFFF
#endif
#ifndef DUP_MASK
#define DUP_MASK 0
#endif
#define NREP(k) ((((DUP_MASK) >> (k)) & 1) ? 2 : 1)
#ifndef TPROBE_PH
#define TPROBE_PH -1
#endif
#ifndef TPROBE_MULT
#define TPROBE_MULT 8
#endif
#ifndef ONE_LAUNCH
#define ONE_LAUNCH 1
#endif

#define LAS __attribute__((address_space(3)))
typedef unsigned short bf16_t;
typedef short bf16x8 __attribute__((ext_vector_type(8)));
typedef short s16x4 __attribute__((ext_vector_type(4)));
typedef float f32x4 __attribute__((ext_vector_type(4)));
typedef float f32x2 __attribute__((ext_vector_type(2)));
typedef unsigned u32x4 __attribute__((ext_vector_type(4)));
typedef unsigned u32x2 __attribute__((ext_vector_type(2)));
typedef __bf16 bf16x2_t __attribute__((ext_vector_type(2)));

constexpr int DM = 2048, BATCH = 4, SEQ = 8192, MTOK = BATCH * SEQ;
constexpr int AW = 1024, HD = 128, NH = 8, SW = 1024, NG = 64, GS = 16, NP = 64;
constexpr int INW = 4096, DFF = 8192, NMODC = 6 * DM;
constexpr int LS = 32;
constexpr int NSC = SEQ / LS;
constexpr int RPG = BATCH * NSC;
constexpr int KU = GS * LS;
constexpr int KA = KU + 128;
constexpr int NT = GS * LS;
constexpr int MSSM = NG * RPG;
constexpr float EPS = 1e-6f;
constexpr float QSCALE = 0.08838834764831845f * 1.4426950408889634f;

constexpr size_t MiB = 1u << 20;
constexpr size_t WS_CTL = 0, CTL_BYTES = 1 * MiB;
constexpr size_t WS_MODP = 1 * MiB;
constexpr size_t WS_MOD = 640 * 1024;
constexpr size_t WS_AL = 4 * MiB;
constexpr size_t WS_WIN = 8 * MiB;
constexpr size_t WS_WGLU = 24 * MiB;
constexpr size_t WS_WOUT = 26 * MiB;
constexpr size_t WS_WFF1 = 34 * MiB;
constexpr size_t WS_WFF2 = 66 * MiB;
constexpr size_t WS_TW = 98 * MiB;
constexpr size_t WS_WS = 138 * MiB;
constexpr size_t WS_XN = 160 * MiB;
constexpr size_t WS_ASSM = 288 * MiB;
constexpr size_t WS_SLOC = 368 * MiB;
constexpr size_t WS_QKV = 400 * MiB;
constexpr size_t WS_ATTP = 592 * MiB;
constexpr size_t WS_LSE = 784 * MiB;
constexpr size_t WS_YACT = 788 * MiB;
constexpr size_t WS_SSMO = 852 * MiB;
constexpr size_t WS_ACT = 288 * MiB;
constexpr size_t WS_H2 = 852 * MiB;
constexpr size_t WS_SSQ = 512 * 1024;
constexpr size_t WS_BIAS2 = 3 * MiB + 512 * 1024;
constexpr size_t WS_END = 980 * MiB;
static_assert(WS_TW + (size_t)NG * NT * KA * 2 <= WS_WS && WS_WS + (size_t)NG * 256 * KU * 2 <= WS_XN, "ws map");
static_assert(WS_ASSM + (size_t)MSSM * KA * 2 <= WS_SLOC && WS_SLOC + (size_t)MSSM * 128 * 4 <= WS_QKV, "ws map");
static_assert(WS_ACT + (size_t)MTOK * DFF * 2 <= WS_SSMO, "ws map");

constexpr int LDS_BYTES = 151552;
constexpr int NPH = 12;
constexpr int ATT_NIT = 3 * BATCH * NH * 64;
constexpr int PFX_BLOCKS = 32, ATT_EARLY_PER = 2;
constexpr int ATT_NIT5 = ATT_NIT - (256 - PFX_BLOCKS) * ATT_EARLY_PER;

__device__ __forceinline__ unsigned pk2(float lo, float hi) { f32x2 v = {lo, hi}; bf16x2_t b = __builtin_convertvector(v, bf16x2_t); return __builtin_bit_cast(unsigned, b); }
__device__ __forceinline__ float bflo(unsigned w) { return __uint_as_float(w << 16); }
__device__ __forceinline__ float bfhi(unsigned w) { return __uint_as_float(w & 0xffff0000u); }
__device__ __forceinline__ float wave_sum(float v) {
#pragma unroll
    for (int o = 1; o < 64; o <<= 1) v += __shfl_xor(v, o);
    return v;
}
#define LDS_WAIT() asm volatile("s_waitcnt lgkmcnt(0)" ::: "memory")

namespace pg8 {
#define PG8_LAS __attribute__((address_space(3)))
constexpr int BM = 256, BK = 64, HALF = 128, HTB = HALF * BK * 2, STAGE_BYTES = 8 * HTB, NXCD = 8, WGM = 4;
__host__ __device__ __forceinline__ int lds_byte(int r, int c) { const int st = (r >> 4) * 2 + (c >> 5), rr = r & 15, cc = c & 31, ob = rr * 64 + cc * 2; return st * 1024 + (ob ^ (((ob >> 9) & 1) << 5)); }
__host__ __device__ __forceinline__ void stage_rc(int b, int& R, int& C) { const int st = b / 1024, sb = b % 1024, swz = sb ^ (((sb >> 9) & 1) << 5); R = (st >> 1) * 16 + swz / 64; C = (st & 1) * 32 + (swz % 64) / 2; }
__host__ __device__ __forceinline__ int perm32(int rho) { const int n = rho >> 4, i = rho & 15; return 8 * (i >> 2) + 4 * n + (i & 3); }

struct Unit { int pm, pn; };
struct Gemm { const bf16_t* A; const bf16_t* Bt; int M, N, K, lda, ldb, bgrp; size_t bgstride; };

struct StaticOrder {
    int nM, nN, nwg, G, c;
    __device__ void init(int M, int N, int G_, int c_) { nM = M / BM; nN = N / BM; nwg = nM * nN; G = G_; c = c_; }
    __device__ bool next(int i, Unit& u) const {
        const long L = (long)i * G + c; if (L >= nwg) return false;
        int wgid = (int)L; { const int q = nwg / NXCD, r = nwg % NXCD, xcd = wgid % NXCD, off = wgid / NXCD; wgid = (xcd < r ? xcd * (q + 1) : r * (q + 1) + (xcd - r) * q) + off; }
        const int nig = WGM * nN, gid = wgid / nig, fm = gid * WGM, gsz = (nM - fm) < WGM ? (nM - fm) : WGM;
        u.pm = fm + ((wgid % nig) % gsz); u.pn = (wgid % nig) / gsz; return true;
    }
};

template <class Epi, bool HALFN = false>
__device__ __forceinline__ void gemm_phase(PG8_LAS unsigned char* lds, const Gemm g, const StaticOrder& S, const Epi& E) {
    const int tid = threadIdx.x, wid = __builtin_amdgcn_readfirstlane(tid >> 6), lane = tid & 63, wr = wid >> 2, wc = wid & 3, fr = lane & 15, fq = lane >> 4;
    const int K = g.K, nt = K / BK;
    unsigned voffA[2], voffB[2];
#pragma unroll
    for (int i = 0; i < 2; ++i) { int R, C; stage_rc(tid * 16 + i * 8192, R, C); const int Rb = Epi::PERM ? ((R & ~31) + perm32(R & 31)) : R;
        voffA[i] = (unsigned)(R * g.lda + C) * 2u; voffB[i] = (unsigned)(Rb * g.ldb + C) * 2u; }
    const size_t kstep = (size_t)(BK * 2);
    const size_t hstepA = (size_t)HALF * g.lda * 2, hstepB = (size_t)HALF * g.ldb * 2;
    const size_t tstepA = 2 * hstepA, tstepB = 2 * hstepB;
    const unsigned ldsw = (unsigned)wid * 1024u;
    const int aoff = lds_byte(wr * 64 + fr, fq * 8), boff = lds_byte(wc * 32 + fr, fq * 8);
#define PG8_SA(b, h) (((b) * 2 + (h)) * HTB)
#define PG8_SB(b, h) ((4 + (b) * 2 + (h)) * HTB)
#define PG8_STAGE(bufoff, gbase, voff) do { _Pragma("unroll") for (int _i = 0; _i < 2; ++_i) \
        __builtin_amdgcn_global_load_lds((const unsigned*)((const char*)(gbase) + (voff)[_i]), (PG8_LAS unsigned*)(lds + (bufoff) + ldsw + _i * 8192), 16, 0, 0); } while (0)
#define PG8_LDA(dst, b, h) do { _Pragma("unroll") for (int m = 0; m < 4; ++m) _Pragma("unroll") for (int k = 0; k < 2; ++k) dst[m][k] = *(const PG8_LAS bf16x8*)(lds + PG8_SA(b, h) + aoff + m * 2048 + k * 1024); } while (0)
#define PG8_LDB(dst, b, h) do { _Pragma("unroll") for (int n = 0; n < 2; ++n) _Pragma("unroll") for (int k = 0; k < 2; ++k) dst[n][k] = *(const PG8_LAS bf16x8*)(lds + PG8_SB(b, h) + boff + n * 2048 + k * 1024); } while (0)
#define PG8_MMA(ai, bj, At, Bt) do { __builtin_amdgcn_s_setprio(1); _Pragma("unroll") for (int m = 0; m < 4; ++m) _Pragma("unroll") for (int n = 0; n < 2; ++n) _Pragma("unroll") for (int k = 0; k < 2; ++k) \
        acc[ai][bj][m][n] = __builtin_amdgcn_mfma_f32_16x16x32_bf16(Bt[n][k], At[m][k], acc[ai][bj][m][n], 0, 0, 0); __builtin_amdgcn_s_setprio(0); } while (0)
#define PG8_WAIT_V(n) asm volatile("s_waitcnt vmcnt(" #n ")" ::: "memory")
#define PG8_WAIT_L(n) asm volatile("s_waitcnt lgkmcnt(" #n ")" ::: "memory")
#define PG8_BAR __builtin_amdgcn_s_barrier()
#define PG8_SCHED __builtin_amdgcn_sched_barrier(0)
#define PG8_BBASE(u) ((const char*)g.Bt + (size_t)(u).pn * tstepB + (g.bgrp ? (size_t)((u).pm / g.bgrp) * g.bgstride : (size_t)0))
    Unit cur, nxt; int ui = 0;
    if (!S.next(0, cur)) return;
    f32x4 acc[2][2][4][2];
#pragma unroll
    for (int a = 0; a < 2; ++a)
#pragma unroll
        for (int b = 0; b < 2; ++b)
#pragma unroll
            for (int m = 0; m < 4; ++m)
#pragma unroll
                for (int n = 0; n < 2; ++n) acc[a][b][m][n] = (f32x4){0.f, 0.f, 0.f, 0.f};
    bf16x8 At[4][2], B0[2][2], B1[2][2];
    const char* cA = (const char*)g.A + (size_t)cur.pm * tstepA; const char* cB = PG8_BBASE(cur);
    PG8_STAGE(PG8_SB(0, 0), cB, voffB); PG8_STAGE(PG8_SB(0, 1), cB + hstepB, voffB); PG8_STAGE(PG8_SA(0, 0), cA, voffA); PG8_STAGE(PG8_SA(0, 1), cA + hstepA, voffA);
    if (wr == 1) PG8_BAR;
    PG8_WAIT_V(2); PG8_BAR;
    PG8_STAGE(PG8_SB(1, 0), cB + kstep, voffB); PG8_STAGE(PG8_SA(1, 0), cA + kstep, voffA); PG8_STAGE(PG8_SB(1, 1), cB + hstepB + kstep, voffB);
    PG8_WAIT_V(6); PG8_BAR;
    for (;;) {
        const bool has_next = S.next(ui + 1, nxt);
        const char* nA = has_next ? (const char*)g.A + (size_t)nxt.pm * tstepA : cA; const char* nB = has_next ? PG8_BBASE(nxt) : cB;
        for (int t = 0; t < nt; t += 2) {
            const bool last = (t == nt - 2);
            const char* a1 = cA + (size_t)(t + 1) * kstep;
            const char* a2 = last ? nA : cA + (size_t)(t + 2) * kstep; const char* b2 = last ? nB : cB + (size_t)(t + 2) * kstep;
            const char* a3 = a2 + kstep; const char* b3 = b2 + kstep;
            PG8_LDB(B0, 0, 0); PG8_LDB(B1, 0, 1); PG8_SCHED; PG8_LDA(At, 0, 0); PG8_STAGE(PG8_SA(1, 1), a1 + hstepA, voffA);
            PG8_WAIT_V(8); PG8_WAIT_L(0); PG8_BAR; PG8_MMA(0, 0, At, B0); if constexpr (!HALFN) PG8_MMA(0, 1, At, B1); PG8_BAR; PG8_SCHED;
            PG8_LDA(At, 0, 1); PG8_STAGE(PG8_SB(0, 0), b2, voffB); PG8_STAGE(PG8_SB(0, 1), b2 + hstepB, voffB); PG8_STAGE(PG8_SA(0, 0), a2, voffA);
            PG8_WAIT_V(8); PG8_WAIT_L(0); PG8_BAR; PG8_MMA(1, 0, At, B0); if constexpr (!HALFN) PG8_MMA(1, 1, At, B1); PG8_BAR; PG8_SCHED;
            PG8_LDB(B0, 1, 0); PG8_LDB(B1, 1, 1); PG8_SCHED; PG8_LDA(At, 1, 0); PG8_STAGE(PG8_SA(0, 1), a2 + hstepA, voffA);
            PG8_WAIT_V(8); PG8_WAIT_L(0); PG8_BAR; PG8_MMA(0, 0, At, B0); if constexpr (!HALFN) PG8_MMA(0, 1, At, B1); PG8_BAR; PG8_SCHED;
            PG8_LDA(At, 1, 1); PG8_STAGE(PG8_SB(1, 0), b3, voffB); PG8_STAGE(PG8_SB(1, 1), b3 + hstepB, voffB); PG8_STAGE(PG8_SA(1, 0), a3, voffA);
            PG8_WAIT_V(8); PG8_WAIT_L(0); PG8_BAR; PG8_MMA(1, 0, At, B0); if constexpr (!HALFN) PG8_MMA(1, 1, At, B1); PG8_BAR; PG8_SCHED;
        }
        if (wr == 0) PG8_BAR;
        E(acc, cur, wr, wc, fr, fq);
        if (!has_next) break;
#pragma unroll
        for (int a = 0; a < 2; ++a)
#pragma unroll
            for (int b = 0; b < 2; ++b)
#pragma unroll
                for (int m = 0; m < 4; ++m)
#pragma unroll
                    for (int n = 0; n < 2; ++n) acc[a][b][m][n] = (f32x4){0.f, 0.f, 0.f, 0.f};
        cur = nxt; cA = nA; cB = nB; ++ui;
        if (wr == 1) PG8_BAR;
    }
    PG8_WAIT_V(0);
    PG8_BAR;
#undef PG8_SA
#undef PG8_SB
#undef PG8_STAGE
#undef PG8_LDA
#undef PG8_LDB
#undef PG8_MMA
#undef PG8_WAIT_V
#undef PG8_WAIT_L
#undef PG8_BAR
#undef PG8_SCHED
#undef PG8_BBASE
}

__device__ __forceinline__ u32x4 pack8(const f32x4 v0, const f32x4 v1) { u32x4 w; w.x = pk2(v0[0], v0[1]); w.y = pk2(v0[2], v0[3]); w.z = pk2(v1[0], v1[1]); w.w = pk2(v1[2], v1[3]); return w; }

struct EpiProj {
    static constexpr bool PERM = true;
    bf16_t* QKV; bf16_t* ASSM; const float* qg; const float* kg; PG8_LAS float* red;
    __device__ __forceinline__ void operator()(const f32x4 (&acc)[2][2][4][2], const Unit& u, int wr, int wc, int fr, int fq) const {
        const int row0 = u.pm * BM + wr * 64 + fr;
        if (u.pn < 8) {
#pragma unroll
            for (int ai = 0; ai < 2; ++ai)
#pragma unroll
                for (int m = 0; m < 4; ++m)
#pragma unroll
                    for (int bj = 0; bj < 2; ++bj) { const f32x4 v0 = acc[ai][bj][m][0], v1 = acc[ai][bj][m][1];
                        float ss = (v0[0] * v0[0] + v0[1] * v0[1]) + (v0[2] * v0[2] + v0[3] * v0[3]) + (v1[0] * v1[0] + v1[1] * v1[1]) + (v1[2] * v1[2] + v1[3] * v1[3]);
                        ss += __shfl_xor(ss, 16); ss += __shfl_xor(ss, 32);
                        if (fq == 0) red[((ai * HALF + wr * 64 + m * 16 + fr) * 2 + bj) * 4 + wc] = ss; }
            asm volatile("s_waitcnt lgkmcnt(0)" ::: "memory"); __builtin_amdgcn_s_barrier(); asm volatile("" ::: "memory");
            const float* gp = (u.pn < 4) ? qg : kg; const float gsc = (u.pn < 4) ? QSCALE : 1.0f;
            f32x4 g0 = *(const f32x4*)(gp + wc * 32 + 8 * fq), g1 = *(const f32x4*)(gp + wc * 32 + 8 * fq + 4); g0 = g0 * gsc; g1 = g1 * gsc;
            const int col0 = u.pn * BM + wc * 32 + 8 * fq;
#pragma unroll
            for (int ai = 0; ai < 2; ++ai)
#pragma unroll
                for (int m = 0; m < 4; ++m) { bf16_t* rowp = QKV + (size_t)(row0 + ai * HALF + m * 16) * 3072 + col0;
#pragma unroll
                    for (int bj = 0; bj < 2; ++bj) { const f32x4 pr = *(const PG8_LAS f32x4*)(red + ((ai * HALF + wr * 64 + m * 16 + fr) * 2 + bj) * 4);
                        const float rstd = rsqrtf(((pr[0] + pr[1]) + (pr[2] + pr[3])) * (1.f / HD) + EPS);
                        *(u32x4*)(rowp + bj * HALF) = pack8(acc[ai][bj][m][0] * rstd * g0, acc[ai][bj][m][1] * rstd * g1); } }
        } else if (u.pn < 12) {
            const int col0 = u.pn * BM + wc * 32 + 8 * fq;
#pragma unroll
            for (int ai = 0; ai < 2; ++ai)
#pragma unroll
                for (int m = 0; m < 4; ++m) { bf16_t* rowp = QKV + (size_t)(row0 + ai * HALF + m * 16) * 3072 + col0;
#pragma unroll
                    for (int bj = 0; bj < 2; ++bj) *(u32x4*)(rowp + bj * HALF) = pack8(acc[ai][bj][m][0], acc[ai][bj][m][1]); }
        } else {
#pragma unroll
            for (int ai = 0; ai < 2; ++ai)
#pragma unroll
                for (int m = 0; m < 4; ++m) { const int row = row0 + ai * HALF + m * 16; const int b = row / SEQ, tt = row % SEQ, sc = tt / LS, s = tt % LS;
#pragma unroll
                    for (int bj = 0; bj < 2; ++bj) { const int colu = (u.pn - 12) * BM + bj * HALF + wc * 32 + 8 * fq; const int gg = colu >> 4, j0 = colu & 15;
                        bf16_t* dst = ASSM + ((size_t)gg * RPG + (size_t)b * NSC + sc) * KA + s * 16 + j0;
                        *(u32x4*)dst = pack8(acc[ai][bj][m][0], acc[ai][bj][m][1]); } }
        }
    }
};
struct EpiSloc {
    static constexpr bool PERM = false;
    float* SLOC;
    __device__ __forceinline__ void operator()(const f32x4 (&acc)[2][2][4][2], const Unit& u, int wr, int wc, int fr, int fq) const {
        const int row0 = u.pm * BM + wr * 64 + fr, col0 = wc * 32 + 4 * fq;
#pragma unroll
        for (int ai = 0; ai < 2; ++ai)
#pragma unroll
            for (int m = 0; m < 4; ++m) { float* rowp = SLOC + (size_t)(row0 + ai * HALF + m * 16) * 128 + col0;
#pragma unroll
                for (int n = 0; n < 2; ++n) *(f32x4*)(rowp + n * 16) = acc[ai][0][m][n]; }
    }
};
__device__ __forceinline__ float gelu_tanh(float v) {
    const float z = 0.7978845608028654f * (v + 0.044715f * v * v * v);
    const float e = __expf(2.f * z);
    const float th = 1.f - 2.f / (1.f + e);
    return 0.5f * v * (1.f + th);
}
struct EpiY {
    static constexpr bool PERM = true;
    const bf16_t* ASSM; bf16_t* YACT; const float* dskip;
    __device__ __forceinline__ void operator()(const f32x4 (&acc)[2][2][4][2], const Unit& u, int wr, int wc, int fr, int fq) const {
        const int row0 = u.pm * BM + wr * 64 + fr;
        const int cb = u.pn * BM + wc * 32 + 8 * fq, i0 = cb & 15;
        u32x4 uwq[8][2]; f32x4 dq[8][2];
#define EY_LOAD(g) do { const int R_ = row0 + ((g) >> 2) * HALF + ((g) & 3) * 16; const int gg_ = R_ / RPG; \
            _Pragma("unroll") for (int bj = 0; bj < 2; ++bj) uwq[g][bj] = *(const u32x4*)(ASSM + (size_t)R_ * KA + cb + bj * HALF); \
            dq[g][0] = *(const f32x4*)(dskip + gg_ * 16 + i0); dq[g][1] = *(const f32x4*)(dskip + gg_ * 16 + i0 + 4); } while (0)
        EY_LOAD(0); EY_LOAD(1);
#pragma unroll
        for (int g = 0; g < 8; ++g) { if (g + 2 < 8) EY_LOAD(g + 2);
            asm volatile("" ::: "memory");
            const int ai = g >> 2, m = g & 3; const int R = row0 + ai * HALF + m * 16; const int gg = R / RPG, rem = R % RPG, b = rem / NSC, sc = rem % NSC;
#pragma unroll
            for (int bj = 0; bj < 2; ++bj) { const int c = cb + bj * HALF; const int t = c >> 4;
                const u32x4 uw = uwq[g][bj]; const f32x4 d0 = dq[g][0], d1 = dq[g][1];
                f32x4 v0 = acc[ai][bj][m][0], v1 = acc[ai][bj][m][1];
                v0[0] += d0[0] * bflo(uw.x); v0[1] += d0[1] * bfhi(uw.x); v0[2] += d0[2] * bflo(uw.y); v0[3] += d0[3] * bfhi(uw.y);
                v1[0] += d1[0] * bflo(uw.z); v1[1] += d1[1] * bfhi(uw.z); v1[2] += d1[2] * bflo(uw.w); v1[3] += d1[3] * bfhi(uw.w);
#pragma unroll
                for (int e = 0; e < 4; ++e) { v0[e] = gelu_tanh(v0[e]); v1[e] = gelu_tanh(v1[e]); }
                const size_t tok = (size_t)b * SEQ + (size_t)sc * LS + t;
                *(u32x4*)(YACT + tok * SW + gg * 16 + i0) = pack8(v0, v1); }
            asm volatile("" ::: "memory"); }
#undef EY_LOAD
    }
};
struct EpiGlu {
    static constexpr bool PERM = true;
    const bf16_t* YACT; bf16_t* SSMO; const float* bglu;
    __device__ __forceinline__ void operator()(const f32x4 (&acc)[2][2][4][2], const Unit& u, int wr, int wc, int fr, int fq) const {
        const int row0 = u.pm * BM + wr * 64 + fr, col0 = u.pn * BM + wc * 32 + 8 * fq;
        f32x4 bq[2][2];
#pragma unroll
        for (int bj = 0; bj < 2; ++bj) { bq[bj][0] = *(const f32x4*)(bglu + col0 + bj * HALF); bq[bj][1] = *(const f32x4*)(bglu + col0 + bj * HALF + 4); }
        u32x4 ywq[8][2];
#define EG_LOAD(g) do { const size_t ro_ = (size_t)(row0 + ((g) >> 2) * HALF + ((g) & 3) * 16) * SW + col0; \
            _Pragma("unroll") for (int bj = 0; bj < 2; ++bj) ywq[g][bj] = *(const u32x4*)(YACT + ro_ + bj * HALF); } while (0)
        EG_LOAD(0); EG_LOAD(1);
#pragma unroll
        for (int g = 0; g < 8; ++g) { if (g + 2 < 8) EG_LOAD(g + 2);
            asm volatile("" ::: "memory");
            const int ai = g >> 2, m = g & 3; const size_t ro = (size_t)(row0 + ai * HALF + m * 16) * SW + col0;
#pragma unroll
            for (int bj = 0; bj < 2; ++bj) { const u32x4 yw = ywq[g][bj];
                f32x4 v0 = acc[ai][bj][m][0] + bq[bj][0], v1 = acc[ai][bj][m][1] + bq[bj][1];
#pragma unroll
                for (int e = 0; e < 4; ++e) { v0[e] = 1.f / (1.f + __expf(-v0[e])); v1[e] = 1.f / (1.f + __expf(-v1[e])); }
                v0[0] *= bflo(yw.x); v0[1] *= bfhi(yw.x); v0[2] *= bflo(yw.y); v0[3] *= bfhi(yw.y);
                v1[0] *= bflo(yw.z); v1[1] *= bfhi(yw.z); v1[2] *= bflo(yw.w); v1[3] *= bfhi(yw.w);
                *(u32x4*)(SSMO + ro + bj * HALF) = pack8(v0, v1); }
            asm volatile("" ::: "memory"); }
#undef EG_LOAD
    }
};
struct EpiRes {
    static constexpr bool PERM = false;
    const float* base; float* out; const float* gate;
    __device__ __forceinline__ void operator()(const f32x4 (&acc)[2][2][4][2], const Unit& u, int wr, int wc, int fr, int fq) const {
        const int row0 = u.pm * BM + wr * 64 + fr, col0 = u.pn * BM + wc * 32 + 4 * fq;
        const int b = (u.pm * BM) / SEQ;
        f32x4 gv[2][2];
#pragma unroll
        for (int bj = 0; bj < 2; ++bj)
#pragma unroll
            for (int n = 0; n < 2; ++n) gv[bj][n] = *(const f32x4*)(gate + (size_t)b * NMODC + col0 + bj * HALF + n * 16);
        f32x4 bs[8][2][2];
#define ER_LOAD(g) do { const size_t off_ = (size_t)(row0 + ((g) >> 2) * HALF + ((g) & 3) * 16) * DM + col0; \
            _Pragma("unroll") for (int bj = 0; bj < 2; ++bj) _Pragma("unroll") for (int n = 0; n < 2; ++n) bs[g][bj][n] = *(const f32x4*)(base + off_ + bj * HALF + n * 16); } while (0)
        ER_LOAD(0); ER_LOAD(1); ER_LOAD(2);
#pragma unroll
        for (int g = 0; g < 8; ++g) { if (g + 3 < 8) ER_LOAD(g + 3);
            asm volatile("" ::: "memory");
            const int ai = g >> 2, m = g & 3; const size_t off = (size_t)(row0 + ai * HALF + m * 16) * DM + col0;
#pragma unroll
            for (int bj = 0; bj < 2; ++bj)
#pragma unroll
                for (int n = 0; n < 2; ++n) *(f32x4*)(out + off + bj * HALF + n * 16) = bs[g][bj][n] + gv[bj][n] * acc[ai][bj][m][n];
            asm volatile("" ::: "memory"); }
#undef ER_LOAD
    }
};
struct EpiSqRelu {
    static constexpr bool PERM = true;
    bf16_t* O;
    __device__ __forceinline__ void operator()(const f32x4 (&acc)[2][2][4][2], const Unit& u, int wr, int wc, int fr, int fq) const {
        const int row0 = u.pm * BM + wr * 64 + fr, col0 = u.pn * BM + wc * 32 + 8 * fq;
#pragma unroll
        for (int ai = 0; ai < 2; ++ai)
#pragma unroll
            for (int m = 0; m < 4; ++m) { bf16_t* rowp = O + (size_t)(row0 + ai * HALF + m * 16) * DFF + col0;
#pragma unroll
                for (int bj = 0; bj < 2; ++bj) { f32x4 v0 = acc[ai][bj][m][0], v1 = acc[ai][bj][m][1];
#pragma unroll
                    for (int e = 0; e < 4; ++e) { const float a0 = fmaxf(v0[e], 0.f), a1 = fmaxf(v1[e], 0.f); v0[e] = a0 * a0; v1[e] = a1 * a1; }
                    *(u32x4*)(rowp + bj * HALF) = pack8(v0, v1); } }
    }
};

struct EpiResN {
    static constexpr bool PERM = true;
    const float* base; float* out; const float* gate; const float* n2g; const float* sc2; bf16_t* H2; float* SSQ;
    __device__ __forceinline__ void operator()(const f32x4 (&acc)[2][2][4][2], const Unit& u, int wr, int wc, int fr, int fq) const {
        const int row0 = u.pm * BM + wr * 64 + fr, col0 = u.pn * BM + wc * 32 + 8 * fq;
        const int b = (u.pm * BM) / SEQ;
        f32x4 gv[2][2], gn[2][2];
#pragma unroll
        for (int bj = 0; bj < 2; ++bj)
#pragma unroll
            for (int n = 0; n < 2; ++n) { const int c = col0 + bj * HALF + 4 * n; gv[bj][n] = *(const f32x4*)(gate + (size_t)b * NMODC + c);
                gn[bj][n] = *(const f32x4*)(n2g + c) * (*(const f32x4*)(sc2 + (size_t)b * NMODC + c) + 1.0f); }
        f32x4 bs[8][2][2];
#define ER_LOAD(g) do { const size_t off_ = (size_t)(row0 + ((g) >> 2) * HALF + ((g) & 3) * 16) * DM + col0; \
            _Pragma("unroll") for (int bj = 0; bj < 2; ++bj) _Pragma("unroll") for (int n = 0; n < 2; ++n) bs[g][bj][n] = *(const f32x4*)(base + off_ + bj * HALF + 4 * n); } while (0)
        ER_LOAD(0); ER_LOAD(1);
#pragma unroll
        for (int g = 0; g < 8; ++g) { if (g + 2 < 8) ER_LOAD(g + 2);
            asm volatile("" ::: "memory");
            const int ai = g >> 2, m = g & 3; const int row = row0 + ai * HALF + m * 16; const size_t off = (size_t)row * DM + col0; float ss = 0.f;
#pragma unroll
            for (int bj = 0; bj < 2; ++bj) { f32x4 x1[2];
#pragma unroll
                for (int n = 0; n < 2; ++n) { x1[n] = bs[g][bj][n] + gv[bj][n] * acc[ai][bj][m][n];
                    *(f32x4*)(out + off + bj * HALF + 4 * n) = x1[n]; ss += (x1[n][0] * x1[n][0] + x1[n][1] * x1[n][1]) + (x1[n][2] * x1[n][2] + x1[n][3] * x1[n][3]); }
                *(u32x4*)(H2 + off + bj * HALF) = pack8(x1[0] * gn[bj][0], x1[1] * gn[bj][1]); }
            ss += __shfl_xor(ss, 16); ss += __shfl_xor(ss, 32);
            if (fq == 0) atomicAdd(SSQ + row, ss);
            asm volatile("" ::: "memory"); }
#undef ER_LOAD
    }
};
struct EpiSqReluN {
    static constexpr bool PERM = true;
    bf16_t* O; const float* SSQ; const float* bias2;
    __device__ __forceinline__ void operator()(const f32x4 (&acc)[2][2][4][2], const Unit& u, int wr, int wc, int fr, int fq) const {
        const int row0 = u.pm * BM + wr * 64 + fr, col0 = u.pn * BM + wc * 32 + 8 * fq;
        const int b = (u.pm * BM) / SEQ;
        f32x4 bv[2][2];
#pragma unroll
        for (int bj = 0; bj < 2; ++bj)
#pragma unroll
            for (int n = 0; n < 2; ++n) bv[bj][n] = *(const f32x4*)(bias2 + (size_t)b * DFF + col0 + bj * HALF + 4 * n);
#pragma unroll
        for (int ai = 0; ai < 2; ++ai)
#pragma unroll
            for (int m = 0; m < 4; ++m) { const int row = row0 + ai * HALF + m * 16; const float rstd = rsqrtf(SSQ[row] * (1.f / DM) + EPS);
                bf16_t* rowp = O + (size_t)row * DFF + col0;
#pragma unroll
                for (int bj = 0; bj < 2; ++bj) { f32x4 v0 = acc[ai][bj][m][0] * rstd + bv[bj][0], v1 = acc[ai][bj][m][1] * rstd + bv[bj][1];
#pragma unroll
                    for (int e = 0; e < 4; ++e) { const float a0 = fmaxf(v0[e], 0.f), a1 = fmaxf(v1[e], 0.f); v0[e] = a0 * a0; v1[e] = a1 * a1; }
                    *(u32x4*)(rowp + bj * HALF) = pack8(v0, v1); } }
    }
};
}

struct Args { const float* in[24]; float* out; unsigned char* ws; int ph_lo, ph_hi; };
enum { I_X = 0, I_C, I_WADA, I_BADA, I_N1G, I_WIN, I_QG, I_KG, I_LRE, I_LIM, I_LSTEP, I_BRE, I_BIM, I_CRE, I_CIM, I_DSKIP, I_WGLU, I_BGLU, I_AOG, I_SOG, I_WOUT, I_N2G, I_WFF1, I_WFF2 };

__device__ __forceinline__ void p0_mod_item(const float* c, const float* w_ada, const float* b_ada, float* MOD, LAS unsigned char* lds, int item, int tid, int wave, int lane) {
    const int cgi = item % 48, ks = item / 48;
    LAS float* sc = (LAS float*)lds; LAS float* red = (LAS float*)(lds + 4096);
    __syncthreads();
    { const int b = tid >> 7, kk = tid & 127; const float v = c[b * DM + ks * 128 + kk]; sc[tid] = v / (1.f + __expf(-v)); }
    __syncthreads();
    f32x4 acc[4];
#pragma unroll
    for (int b = 0; b < 4; ++b) acc[b] = (f32x4){0.f, 0.f, 0.f, 0.f};
    const float* wp = w_ada + (size_t)(ks * 128 + wave * 16) * NMODC + cgi * 256 + lane * 4;
    f32x4 w[16];
#pragma unroll
    for (int kk = 0; kk < 16; ++kk) w[kk] = *(const f32x4*)(wp + (size_t)kk * NMODC);
#pragma unroll
    for (int kk = 0; kk < 16; ++kk) {
#pragma unroll
        for (int b = 0; b < 4; ++b) { const float s_ = sc[b * 128 + wave * 16 + kk]; acc[b] += w[kk] * s_; }
    }
#pragma unroll
    for (int b = 0; b < 4; ++b) *(LAS f32x4*)(red + (wave * 4 + b) * 256 + lane * 4) = acc[b];
    __syncthreads();
    for (int u = tid; u < 1024; u += 512) { const int b = u >> 8, col = u & 255; float s_ = 0.f;
#pragma unroll
        for (int w_ = 0; w_ < 8; ++w_) s_ += red[(w_ * 4 + b) * 256 + col];
        if (ks == 0) s_ += b_ada[cgi * 256 + col];
        atomicAdd(MOD + (size_t)b * NMODC + cgi * 256 + col, s_); }
}

__device__ __forceinline__ void p0_transpose_item(const float* W, int K, int N, bf16_t* WT, LAS float* scr, int item, int lane) {
    const int nblk = N / 32, kb = item / nblk, nb = item % nblk, k0 = 64 * kb, n0 = 32 * nb;
    { const int c4 = (lane & 7) * 4, kr = lane >> 3;
      f32x4 v[8];
#pragma unroll
      for (int i = 0; i < 8; ++i) v[i] = *(const f32x4*)(W + (size_t)(k0 + 8 * i + kr) * N + n0 + c4);
#pragma unroll
      for (int i = 0; i < 8; ++i) { LAS float* d = scr + (8 * i + kr) * 33 + c4; d[0] = v[i][0]; d[1] = v[i][1]; d[2] = v[i][2]; d[3] = v[i][3]; } }
    LDS_WAIT(); asm volatile("" ::: "memory");
    const int c = lane & 7;
#pragma unroll
    for (int j = 0; j < 4; ++j) { const int n = (lane >> 3) + 8 * j; const LAS float* s = scr + (8 * c) * 33 + n;
        u32x4 o; o.x = pk2(s[0 * 33], s[1 * 33]); o.y = pk2(s[2 * 33], s[3 * 33]); o.z = pk2(s[4 * 33], s[5 * 33]); o.w = pk2(s[6 * 33], s[7 * 33]);
        *(u32x4*)(WT + (size_t)(n0 + n) * K + k0 + 8 * c) = o; }
    LDS_WAIT(); asm volatile("" ::: "memory");
}

__device__ __forceinline__ void p0_ssm_item(const Args& a, LAS unsigned char* lds, int item, int tid) {
    const int g = item >> 2, q = item & 3;
    unsigned char* ws = a.ws;
    bf16_t* TW = (bf16_t*)(ws + WS_TW); bf16_t* WSm = (bf16_t*)(ws + WS_WS); float* AL = (float*)(ws + WS_AL);
    LAS float* apr = (LAS float*)lds;
    LAS float* api = apr + (LS + 1) * 64;
    LAS float* bbr = api + (LS + 1) * 64;
    LAS float* bbi = bbr + 1024;
    LAS float* ccr = bbi + 1024;
    LAS float* cci = ccr + 1024;
    LAS float* Kt8 = cci + 1024;
    LAS float* Xr = Kt8 + 8 * 260;
    LAS float* Xi = Xr + 8192;
    const float* lam_re = a.in[I_LRE]; const float* lam_im = a.in[I_LIM];
    __syncthreads();
    const float st = expf(a.in[I_LSTEP][g]);
    for (int u = tid; u < (LS + 1) * 64; u += 512) { const int tau = u >> 6, p = u & 63;
        const float lr = lam_re[g * 64 + p] * st, li = lam_im[g * 64 + p] * st;
        const float mag = __expf(lr * (float)tau);
        float rev = li * (float)tau * 0.15915494309189535f; rev -= rintf(rev);
        apr[u] = mag * __builtin_amdgcn_cosf(rev); api[u] = mag * __builtin_amdgcn_sinf(rev); }
    for (int u = tid; u < 1024; u += 512) { const int i = u >> 6, p = u & 63; ccr[u] = a.in[I_CRE][(g * 16 + i) * 64 + p]; cci[u] = a.in[I_CIM][(g * 16 + i) * 64 + p]; }
    __syncthreads();
    for (int u = tid; u < 1024; u += 512) { const int p = u >> 4, j = u & 15;
        const float lr = lam_re[g * 64 + p], li = lam_im[g * 64 + p];
        const float x = apr[64 + p] - 1.f, y = api[64 + p];
        const float den = 1.f / (lr * lr + li * li);
        const float cr_ = (x * lr + y * li) * den, ci_ = (y * lr - x * li) * den;
        const float br = a.in[I_BRE][(g * 64 + p) * 16 + j], bi = a.in[I_BIM][(g * 64 + p) * 16 + j];
        bbr[u] = cr_ * br - ci_ * bi; bbi[u] = cr_ * bi + ci_ * br; }
    __syncthreads();
    for (int u = tid; u < 8192; u += 512) { const int tl = u >> 10, p = (u >> 4) & 63, j = u & 15; const int tau = 8 * q + tl;
        const float ar = apr[tau * 64 + p], ai = api[tau * 64 + p]; const float br = bbr[p * 16 + j], bi = bbi[p * 16 + j];
        Xr[u] = ar * br - ai * bi; Xi[u] = ar * bi + ai * br; }
    __syncthreads();
    for (int u = tid; u < 2048; u += 512) { const int tl = u >> 8, i = (u >> 4) & 15, j = u & 15; float sacc = 0.f;
#pragma unroll 8
        for (int p = 0; p < 64; ++p) sacc += ccr[i * 64 + p] * Xr[(tl * 64 + p) * 16 + j] - cci[i * 64 + p] * Xi[(tl * 64 + p) * 16 + j];
        Kt8[tl * 260 + (u & 255)] = sacc; }
    __syncthreads();
    LAS unsigned* Kp = (LAS unsigned*)(Xi + 8192);
    for (int u = tid; u < 1024; u += 512) { const int tl = u >> 7, e = u & 127; Kp[tl * 132 + e] = pk2(Kt8[tl * 260 + 2 * e], Kt8[tl * 260 + 2 * e + 1]); }
    __syncthreads();
    constexpr int RQ = NT / 4, PCS = KA / 8, UPC = KU / 8;
    for (int u = tid; u < 8 * 2 * LS * 16 * 2; u += 512) {
        const int jh = u & 1, tl = (u >> 1) & 7, i = (u >> 4) & 15, t = (u >> 8) & (LS - 1), up = u >> 13; const int d = 8 * q + tl;
        const int sidx = up ? t + d : t - d;
        const bool valid = up ? (d >= 1 && sidx < LS) : (sidx >= 0);
        if (valid) {
            unsigned w[4];
            if (!up) { const u32x4 kq = *(const LAS u32x4*)(Kp + tl * 132 + i * 8 + 4 * jh); w[0] = kq.x; w[1] = kq.y; w[2] = kq.z; w[3] = kq.w; }
            else { w[0] = w[1] = w[2] = w[3] = 0u; }
            *(u32x4*)(TW + ((size_t)(g * NT + t * 16 + i)) * KA + (2 * sidx + jh) * 8) = (u32x4){w[0], w[1], w[2], w[3]};
        }
    }
    for (int u = tid; u < RQ * (PCS - UPC); u += 512) {
        const int r = q * RQ + u / (PCS - UPC), pc = UPC + u % (PCS - UPC); const int t = r >> 4, i = r & 15;
        unsigned w[4];
        const int pp = (pc - UPC) * 8, p0 = pp & 63, isim = pp >> 6;
#pragma unroll
        for (int e2 = 0; e2 < 4; ++e2) { float v[2];
#pragma unroll
            for (int h = 0; h < 2; ++h) { const int p = p0 + 2 * e2 + h; const float ar = apr[(t + 1) * 64 + p], ai = api[(t + 1) * 64 + p];
                const float zr = ccr[i * 64 + p] * ar - cci[i * 64 + p] * ai, zi = ccr[i * 64 + p] * ai + cci[i * 64 + p] * ar; v[h] = isim ? -zi : zr; }
            w[e2] = pk2(v[0], v[1]); }
        *(u32x4*)(TW + ((size_t)(g * NT + r)) * KA + pc * 8) = (u32x4){w[0], w[1], w[2], w[3]};
    }
    for (int u = tid; u < 64 * UPC; u += 512) {
        const int pr = q * 64 + u / UPC, pc = u % UPC; const int s = pc >> 1, j0 = (pc & 1) * 8;
        unsigned w[4];
        if (q < 2) { const int p = pr & 63; const float ar = apr[(LS - 1 - s) * 64 + p], ai = api[(LS - 1 - s) * 64 + p];
#pragma unroll
            for (int e2 = 0; e2 < 4; ++e2) { float v[2];
#pragma unroll
                for (int h = 0; h < 2; ++h) { const int j = j0 + 2 * e2 + h; const float br = bbr[p * 16 + j], bi = bbi[p * 16 + j];
                    const float zr = ar * br - ai * bi, zi = ar * bi + ai * br; v[h] = (q == 0) ? zr : zi; }
                w[e2] = pk2(v[0], v[1]); }
        } else { w[0] = w[1] = w[2] = w[3] = 0u; }
        *(u32x4*)(WSm + ((size_t)(g * 256 + pr)) * KU + pc * 8) = (u32x4){w[0], w[1], w[2], w[3]};
    }
    if (q == 0 && tid < 64) { AL[(g * 64 + tid) * 2] = apr[LS * 64 + tid]; AL[(g * 64 + tid) * 2 + 1] = api[LS * 64 + tid]; }
}

__device__ __forceinline__ void norm_mod_phase(const float* src, bf16_t* dst, const float* gvec, const float* shp, const float* scp, int npart, const float* bias_sh, const float* bias_sc, int gw, int lane) {
    const int b = gw >> 9, r0 = gw & 511;
    f32x4 gs[8], sh[8];
#pragma unroll
    for (int j = 0; j < 8; ++j) { const int col = 4 * (j * 64 + lane);
        sh[j] = bias_sh ? *(const f32x4*)(bias_sh + col) : (f32x4){0.f, 0.f, 0.f, 0.f};
        gs[j] = bias_sc ? *(const f32x4*)(bias_sc + col) : (f32x4){0.f, 0.f, 0.f, 0.f}; }
#pragma unroll 1
    for (int s = 0; s < npart; ++s) {
#pragma unroll
        for (int j = 0; j < 8; ++j) { const int col = 4 * (j * 64 + lane);
            sh[j] += *(const f32x4*)(shp + (size_t)s * 4 * NMODC + (size_t)b * NMODC + col); gs[j] += *(const f32x4*)(scp + (size_t)s * 4 * NMODC + (size_t)b * NMODC + col); }
        asm volatile("" ::: "memory");
    }
#pragma unroll
    for (int j = 0; j < 8; ++j) { const int col = 4 * (j * 64 + lane); const f32x4 gvv = *(const f32x4*)(gvec + col); gs[j] = gvv * (gs[j] + 1.0f); }
    for (int k = 0; k < 16; ++k) {
        const size_t row = (size_t)b * SEQ + r0 + 512 * k;
        const f32x4* xr = (const f32x4*)(src + row * DM) + lane;
        f32x4 v[8]; float ss = 0.f;
#pragma unroll
        for (int j = 0; j < 8; ++j) { v[j] = xr[64 * j]; ss += (v[j][0] * v[j][0] + v[j][1] * v[j][1]) + (v[j][2] * v[j][2] + v[j][3] * v[j][3]); }
        const float rstd = rsqrtf(wave_sum(ss) * (1.f / DM) + EPS);
        u32x2* o8 = (u32x2*)(dst + row * DM) + lane;
#pragma unroll
        for (int j = 0; j < 8; ++j) { const f32x4 o = v[j] * rstd * gs[j] + sh[j]; o8[64 * j] = (u32x2){pk2(o[0], o[1]), pk2(o[2], o[3])}; }
    }
}

__device__ __forceinline__ s16x4 vtr(const LAS unsigned char* p) { return __builtin_bit_cast(s16x4, __builtin_amdgcn_ds_read_tr16_b64_v4i16((LAS s16x4*)p)); }
constexpr int AROW = 288, AVOFF = 256 * AROW;
__device__ __forceinline__ void attn_item(const bf16_t* QKV, bf16_t* ATTP, float* LSE, LAS unsigned char* lds, int it, int tid, int wave, int lane) {
    const int rj = it & 63, h = (it >> 6) & 7, b = (it >> 9) & 3, pi = it >> 11;
    const int dsh = 2 * pi, nbsh = 6 - dsh;
    const int r = rj >> nbsh, j = rj & ((1 << nbsh) - 1);
    const int fr = lane & 15, fq = lane >> 4;
    const size_t tokbase = (size_t)b * SEQ;
    __syncthreads();
    {
        u32x4 kv[8], vv[8];
#pragma unroll
        for (int i = 0; i < 8; ++i) { const int piece = tid + 512 * i, row = piece >> 4, pc = piece & 15; const int idx = 128 * (j - 1) + row;
            const size_t tok = tokbase + ((size_t)(idx >= 0 ? idx : 0) << dsh) + r; const bf16_t* src = QKV + tok * 3072 + 1024 + h * 128 + pc * 8;
            kv[i] = *(const u32x4*)src; vv[i] = *(const u32x4*)(src + 1024); }
#pragma unroll
        for (int i = 0; i < 8; ++i) { const int piece = tid + 512 * i, row = piece >> 4, pc = piece & 15;
            *(LAS u32x4*)(lds + row * AROW + pc * 16) = kv[i]; *(LAS u32x4*)(lds + AVOFF + row * AROW + pc * 16) = vv[i]; }
    }
    const int qi = 16 * wave + fr; const size_t qtok = tokbase + ((size_t)(128 * j + qi) << dsh) + r;
    bf16x8 qf[4];
    { const bf16_t* qp = QKV + qtok * 3072 + h * 128 + 8 * fq;
#pragma unroll
      for (int ks = 0; ks < 4; ++ks) qf[ks] = *(const bf16x8*)(qp + 32 * ks); }
    __syncthreads();
    const float slope2 = exp2f(-(float)(h + 1)) * (float)(1 << dsh) * 1.4426950408889634f;
    const float c0 = slope2 * ((float)(4 * fq - fr) - 128.f);
    f32x4 sacc[9];
#pragma unroll
    for (int kbi = 0; kbi < 9; ++kbi) { f32x4 acc;
#pragma unroll
        for (int i = 0; i < 4; ++i) acc[i] = fmaf(slope2, (float)(16 * kbi + i), c0);
        const LAS unsigned char* kp = lds + (16 * (wave + kbi) + fr) * AROW + fq * 16;
#pragma unroll
        for (int ks = 0; ks < 4; ++ks) { const bf16x8 kf = *(const LAS bf16x8*)(kp + ks * 64); acc = __builtin_amdgcn_mfma_f32_16x16x32_bf16(kf, qf[ks], acc, 0, 0, 0); }
        sacc[kbi] = acc; }
    const int rel0 = 4 * fq - fr;
#pragma unroll
    for (int i = 0; i < 4; ++i) { if (rel0 + i < 0) sacc[0][i] = -INFINITY; if (rel0 + i > 0) sacc[8][i] = -INFINITY; }
    if (j == 0) {
#pragma unroll
        for (int kbi = 0; kbi < 8; ++kbi) if (wave + kbi < 8) sacc[kbi] = (f32x4){-INFINITY, -INFINITY, -INFINITY, -INFINITY};
    }
    float mx = -INFINITY;
#pragma unroll
    for (int kbi = 0; kbi < 9; ++kbi)
#pragma unroll
        for (int i = 0; i < 4; ++i) mx = fmaxf(mx, sacc[kbi][i]);
    mx = fmaxf(mx, __shfl_xor(mx, 16)); mx = fmaxf(mx, __shfl_xor(mx, 32));
    float sum = 0.f;
#pragma unroll
    for (int kbi = 0; kbi < 9; ++kbi)
#pragma unroll
        for (int i = 0; i < 4; ++i) { const float p = __builtin_amdgcn_exp2f(sacc[kbi][i] - mx); sacc[kbi][i] = p; sum += p; }
    sum += __shfl_xor(sum, 16); sum += __shfl_xor(sum, 32);
    bf16x8 pf[5];
#pragma unroll
    for (int s = 0; s < 5; ++s) { const f32x4 pa = sacc[2 * s]; const f32x4 pb = (2 * s + 1 < 9) ? sacc[(2 * s + 1 < 9) ? 2 * s + 1 : 0] : (f32x4){0.f, 0.f, 0.f, 0.f};
        const u32x4 w = (u32x4){pk2(pa[0], pa[1]), pk2(pa[2], pa[3]), pk2(pb[0], pb[1]), pk2(pb[2], pb[3])}; pf[s] = __builtin_bit_cast(bf16x8, w); }
    f32x4 o[8];
#pragma unroll
    for (int eb = 0; eb < 8; ++eb) o[eb] = (f32x4){0.f, 0.f, 0.f, 0.f};
    const LAS unsigned char* vb = lds + AVOFF + (4 * fq + (fr >> 2)) * AROW + (4 * (fr & 3)) * 2;
#pragma unroll
    for (int s = 0; s < 5; ++s) { const int kbA = wave + 2 * s, kbB = (s < 4) ? kbA + 1 : kbA;
#pragma unroll
        for (int eb = 0; eb < 8; ++eb) { const s16x4 lo = vtr(vb + kbA * 16 * AROW + eb * 32), hi = vtr(vb + kbB * 16 * AROW + eb * 32);
            const bf16x8 vf = (bf16x8){lo[0], lo[1], lo[2], lo[3], hi[0], hi[1], hi[2], hi[3]};
            o[eb] = __builtin_amdgcn_mfma_f32_16x16x32_bf16(vf, pf[s], o[eb], 0, 0, 0); } }
    const float inv = 1.f / sum;
    bf16_t* op = ATTP + ((size_t)pi * MTOK + qtok) * AW + h * 128 + 4 * fq;
#pragma unroll
    for (int eb = 0; eb < 8; ++eb) *(u32x2*)(op + 16 * eb) = (u32x2){pk2(o[eb][0] * inv, o[eb][1] * inv), pk2(o[eb][2] * inv, o[eb][3] * inv)};
    if (fq == 0) LSE[((size_t)pi * MTOK + qtok) * 8 + h] = (mx + log2f(sum)) * 0.6931471805599453f;
}

#define XB_TMO      128
#define XB_XCNT(j)  (256  + 64 * (j))
#define XB_XSUB(j)  (1280 + 64 * (j))
#define XB_XGEN(j)  (2304 + 64 * (j))
#define XB_TOP      3328
#define XB_TOPGEN   3392
#define XCD_BAR_WORDS 3456
#define XB_SPIN_CAP (1u << 22)
__device__ __forceinline__ unsigned xb_ld(unsigned* p)              { return __hip_atomic_load(p, __ATOMIC_RELAXED, __HIP_MEMORY_SCOPE_AGENT); }
__device__ __forceinline__ unsigned xb_add(unsigned* p, unsigned v) { return __hip_atomic_fetch_add(p, v, __ATOMIC_RELAXED, __HIP_MEMORY_SCOPE_AGENT); }
__device__ __forceinline__ unsigned xb_xcc_id() { return (unsigned)__builtin_amdgcn_s_getreg((3 << 11) | 20) & 0xFu; }
#define XB_SPIN(cond, bar) do { unsigned _sp = 0; while (cond) { __builtin_amdgcn_s_sleep(1); \
    if ((++_sp & 255u) == 0u) { if (xb_ld(&(bar)[XB_TMO])) break; if (_sp > XB_SPIN_CAP) { atomicAdd(&(bar)[XB_TMO], 1u); break; } } } } while (0)
struct XcdBarrier { unsigned* bar; unsigned x; volatile LAS unsigned* st; };
__device__ __forceinline__ XcdBarrier xcd_barrier_post(unsigned* bar, volatile LAS unsigned* st) {
    XcdBarrier b; b.bar = bar; b.x = xb_xcc_id(); b.st = st;
    if (threadIdx.x == 0) (void)xb_add(&bar[XB_XCNT(b.x)], 1u);
    return b;
}
__device__ __forceinline__ void xcd_barrier_complete(unsigned* bar, unsigned x, unsigned& nloc, unsigned& nx) {
    const unsigned G = gridDim.x * gridDim.y * gridDim.z;
    unsigned sum, cnt, mine, sp = 0u;
    for (;;) {
        sum = 0u; cnt = 0u; mine = 0u;
#pragma unroll
        for (unsigned j = 0; j < 16; ++j) { const unsigned c = xb_ld(&bar[XB_XCNT(j)]); sum += c; cnt += (c > 0u) ? 1u : 0u; mine = (j == x) ? c : mine; }
        if (sum == G) break;
        __builtin_amdgcn_s_sleep(1);
        if ((++sp & 255u) == 0u) { if (xb_ld(&bar[XB_TMO])) break; if (sp > XB_SPIN_CAP) { atomicAdd(&bar[XB_TMO], 1u); break; } }
    }
    nloc = mine > 0u ? mine : 1u; nx = cnt > 0u ? cnt : 1u;
}
__device__ __forceinline__ void xcd_barrier(const XcdBarrier& b) {
    asm volatile("s_waitcnt vmcnt(0)" ::: "memory");
    __syncthreads();
    if (threadIdx.x == 0) {
        unsigned* bar = b.bar;
        __builtin_amdgcn_s_waitcnt(0);
        unsigned nloc = b.st[0], nx = b.st[1];
        if (nloc == 0u) { xcd_barrier_complete(bar, b.x, nloc, nx); b.st[0] = nloc; b.st[1] = nx; }
        const unsigned old = xb_add(&bar[XB_XSUB(b.x)], 1u);
        const unsigned gen = old / nloc;
        if (old + 1u == (gen + 1u) * nloc) {
            __builtin_amdgcn_fence(__ATOMIC_RELEASE, "agent");
            asm volatile("s_waitcnt vmcnt(0)" ::: "memory");
            const unsigned og = xb_add(&bar[XB_TOP], 1u);
            const unsigned tg = og / nx;
            if (og + 1u == (tg + 1u) * nx) xb_add(&bar[XB_TOPGEN], 1u);
            else XB_SPIN(xb_ld(&bar[XB_TOPGEN]) == tg, bar);
            __builtin_amdgcn_fence(__ATOMIC_ACQUIRE, "agent");
            xb_add(&bar[XB_XGEN(b.x)], 1u);
            asm volatile("s_waitcnt vmcnt(0)" ::: "memory");
        } else {
            XB_SPIN(xb_ld(&bar[XB_XGEN(b.x)]) == gen, bar);
            __builtin_amdgcn_fence(__ATOMIC_ACQUIRE, "agent");
            asm volatile("s_waitcnt vmcnt(0)" ::: "memory");
        }
    }
    __syncthreads();
}

__global__ void __launch_bounds__(512, 2) fwd_kernel(Args a) {
    extern __shared__ __attribute__((aligned(16))) unsigned char smem[];
    LAS unsigned char* lds = (LAS unsigned char*)smem;
    const int tid = threadIdx.x, lane = tid & 63, wave = __builtin_amdgcn_readfirstlane(tid >> 6);
    const int G = gridDim.x, bid = blockIdx.x;
    const int gw = bid * 8 + wave, NGW = G * 8;
    const int vbid = (G % 8 == 0) ? (bid % 8) * (G / 8) + bid / 8 : bid;
    unsigned char* ws = a.ws;
    float* MODP = (float*)(ws + WS_MODP); float* MOD = (float*)(ws + WS_MOD); float* AL = (float*)(ws + WS_AL);
    bf16_t* WIN = (bf16_t*)(ws + WS_WIN); bf16_t* WGLU = (bf16_t*)(ws + WS_WGLU); bf16_t* WOUT = (bf16_t*)(ws + WS_WOUT);
    bf16_t* WFF1 = (bf16_t*)(ws + WS_WFF1); bf16_t* WFF2 = (bf16_t*)(ws + WS_WFF2);
    bf16_t* TW = (bf16_t*)(ws + WS_TW); bf16_t* WSm = (bf16_t*)(ws + WS_WS);
    bf16_t* XN = (bf16_t*)(ws + WS_XN); bf16_t* ASSM = (bf16_t*)(ws + WS_ASSM); float* SLOC = (float*)(ws + WS_SLOC);
    bf16_t* QKV = (bf16_t*)(ws + WS_QKV); bf16_t* ATTP = (bf16_t*)(ws + WS_ATTP); float* LSE = (float*)(ws + WS_LSE);
    bf16_t* YACT = (bf16_t*)(ws + WS_YACT); bf16_t* SSMO = (bf16_t*)(ws + WS_SSMO); bf16_t* ACT = (bf16_t*)(ws + WS_ACT);
    const int lo = a.ph_lo, hi = a.ph_hi;
#define IN(k) (((PH_MASK >> (k)) & 1) && lo <= (k) && (k) < hi)
#if ONE_LAUNCH
    cg::grid_group grid = cg::this_grid();
    volatile LAS unsigned* xst = (volatile LAS unsigned*)(lds + LDS_BYTES - 4096);
    if (tid == 0) { xst[0] = 0u; xst[1] = 0u; }
    __syncthreads();
    const XcdBarrier xbar = xcd_barrier_post((unsigned*)(ws + WS_CTL) + 4096, xst);
    volatile LAS unsigned long long* tsl = (volatile LAS unsigned long long*)(lds + LDS_BYTES - 2048);
    if (TPROBE_PH >= 0 && bid == 0 && tid == 0) tsl[0] = __builtin_amdgcn_s_memrealtime();
    if (a.ph_hi > 1000) { __threadfence(); grid.sync(); }
#define SEAM(k) do { if (IN(k) && IN((k) + 1)) xcd_barrier(xbar); if (TPROBE_PH >= 0 && bid == 0 && tid == 0) tsl[(k) + 1] = __builtin_amdgcn_s_memrealtime(); } while (0)
#else
#define SEAM(k) do { } while (0)
#endif

    if (IN(0)) for (int rep = 0; rep < NREP(0); ++rep) {
        for (int it = bid; it < 768; it += G) p0_mod_item(a.in[I_C], a.in[I_WADA], a.in[I_BADA], MOD, lds, it, tid, wave, lane);
        if (TPROBE_PH >= 0 && bid == 0 && tid == 0) tsl[20] = __builtin_amdgcn_s_memrealtime();
        for (int it = bid; it < 256; it += G) p0_ssm_item(a, lds, it, tid);
        __syncthreads();
        if (TPROBE_PH >= 0 && bid == 0 && tid == 0) tsl[21] = __builtin_amdgcn_s_memrealtime();
        LAS float* scr = (LAS float*)(lds + wave * 16384);
        constexpr int T_IN = (DM / 64) * (INW / 32), T_GLU = (SW / 64) * (SW / 32), T_OUT = (DM / 64) * (DM / 32), T_FF1 = (DM / 64) * (DFF / 32), T_FF2 = (DFF / 64) * (DM / 32);
        for (int it = gw; it < T_IN + T_GLU + T_OUT + T_FF1 + T_FF2; it += NGW) {
            int r = it;
            if (r < T_IN) { p0_transpose_item(a.in[I_WIN], DM, INW, WIN, scr, r, lane); continue; } r -= T_IN;
            if (r < T_GLU) { p0_transpose_item(a.in[I_WGLU], SW, SW, WGLU, scr, r, lane); continue; } r -= T_GLU;
            if (r < T_OUT) { p0_transpose_item(a.in[I_WOUT], DM, DM, WOUT, scr, r, lane); continue; } r -= T_OUT;
            if (r < T_FF1) { p0_transpose_item(a.in[I_WFF1], DM, DFF, WFF1, scr, r, lane); continue; } r -= T_FF1;
            p0_transpose_item(a.in[I_WFF2], DFF, DM, WFF2, scr, r, lane);
        }
        if (TPROBE_PH >= 0 && bid == 0 && tid == 0) tsl[22] = __builtin_amdgcn_s_memrealtime();
    }
    SEAM(0);
    if (IN(1)) for (int rep = 0; rep < NREP(1); ++rep) {
        norm_mod_phase(a.in[I_X], XN, a.in[I_N1G], MOD + 0, MOD + DM, 1, nullptr, nullptr, gw, lane);
    }
    SEAM(1);
    if (IN(2)) for (int rep = 0; rep < NREP(2); ++rep) {
        pg8::Gemm g{XN, WIN, MTOK, INW, DM, DM, DM, 0, 0}; pg8::StaticOrder S; S.init(MTOK, INW, G, bid);
        pg8::EpiProj E{QKV, ASSM, a.in[I_QG], a.in[I_KG], (LAS float*)(lds + pg8::STAGE_BYTES)};
        pg8::gemm_phase<pg8::EpiProj>(lds, g, S, E);
    }
    SEAM(2);
    if (IN(3)) {
        pg8::Gemm g{ASSM, WSm, MSSM, 256, KU, KA, KU, RPG / 256, (size_t)256 * KU * 2}; pg8::StaticOrder S; S.init(MSSM, 256, G, bid);
        pg8::EpiSloc E{SLOC};
        pg8::gemm_phase<pg8::EpiSloc, true>(lds, g, S, E);
    }
    SEAM(3);
    if (IN(4)) {
        if (bid >= PFX_BLOCKS) {
            for (int k = 0; k < ATT_EARLY_PER; ++k) { const int it = ATT_NIT5 + (bid - PFX_BLOCKS) + (G - PFX_BLOCKS) * k; if (it < ATT_NIT) attn_item(QKV, ATTP, LSE, lds, it, tid, wave, lane); }
            __syncthreads();
        } else for (int it = bid * 8 + wave; it < BATCH * NG; it += PFX_BLOCKS * 8) {
            const int b = it >> 6, g = it & 63; const int p = lane;
            const float alr = AL[(g * 64 + p) * 2], ali = AL[(g * 64 + p) * 2 + 1];
            float hr = 0.f, hi_ = 0.f;
            const size_t R0 = (size_t)g * RPG + (size_t)b * NSC;
            for (int sc0 = 0; sc0 < NSC; sc0 += 32) {
                float sr[32], si[32];
#pragma unroll
                for (int k = 0; k < 32; ++k) { sr[k] = SLOC[(R0 + sc0 + k) * 128 + p]; si[k] = SLOC[(R0 + sc0 + k) * 128 + 64 + p]; }
#pragma unroll
                for (int k = 0; k < 32; ++k) { bf16_t* dst = ASSM + (R0 + sc0 + k) * KA + KU + p;
                    dst[0] = (bf16_t)(pk2(hr, 0.f) & 0xffffu); dst[64] = (bf16_t)(pk2(hi_, 0.f) & 0xffffu);
                    const float nr = alr * hr - ali * hi_ + sr[k], ni = alr * hi_ + ali * hr + si[k]; hr = nr; hi_ = ni; }
            }
        }
    }
    SEAM(4);
    if (IN(5)) {
        for (int rep = 0; rep < NREP(12); ++rep) {
            pg8::Gemm g{ASSM, TW, MSSM, NT, KA, KA, KA, RPG / 256, (size_t)NT * KA * 2}; pg8::StaticOrder S; S.init(MSSM, NT, G, bid);
            pg8::EpiY E{ASSM, YACT, a.in[I_DSKIP]};
            pg8::gemm_phase<pg8::EpiY>(lds, g, S, E);
        }
        for (int rep = 0; rep < NREP(5); ++rep)
        for (int it = vbid; it < ATT_NIT5; it += G) attn_item(QKV, ATTP, LSE, lds, it, tid, wave, lane);
        __syncthreads();
    }
    SEAM(5);
    if (IN(6)) {
        pg8::Gemm g{YACT, WGLU, MTOK, SW, SW, SW, SW, 0, 0}; pg8::StaticOrder S; S.init(MTOK, SW, G, bid);
        pg8::EpiGlu E{YACT, SSMO, a.in[I_BGLU]};
        pg8::gemm_phase<pg8::EpiGlu>(lds, g, S, E);
    }
    SEAM(6);
    if (IN(7)) for (int rep = 0; rep < NREP(7); ++rep) {
        {
            float* BIAS2 = (float*)(ws + WS_BIAS2);
            u32x4 w[4][4];
#pragma unroll
            for (int c = 0; c < 4; ++c) { const u32x4* wr_ = (const u32x4*)(WFF1 + (size_t)(gw + NGW * c) * DM) + lane;
#pragma unroll
                for (int j = 0; j < 4; ++j) w[c][j] = (gw + NGW * c < DFF) ? wr_[64 * j] : (u32x4){0u, 0u, 0u, 0u}; }
#pragma unroll 1
            for (int b = 0; b < 4; ++b) {
                f32x4 s0[4], s1[4];
#pragma unroll
                for (int j = 0; j < 4; ++j) { const int k0 = (j * 64 + lane) * 8; s0[j] = *(const f32x4*)(MOD + (size_t)b * NMODC + 3 * DM + k0); s1[j] = *(const f32x4*)(MOD + (size_t)b * NMODC + 3 * DM + k0 + 4); }
                float acc[4];
#pragma unroll
                for (int c = 0; c < 4; ++c) { float a_ = 0.f;
#pragma unroll
                    for (int j = 0; j < 4; ++j) a_ += s0[j][0] * bflo(w[c][j].x) + s0[j][1] * bfhi(w[c][j].x) + s0[j][2] * bflo(w[c][j].y) + s0[j][3] * bfhi(w[c][j].y) + s1[j][0] * bflo(w[c][j].z) + s1[j][1] * bfhi(w[c][j].z) + s1[j][2] * bflo(w[c][j].w) + s1[j][3] * bfhi(w[c][j].w);
                    acc[c] = wave_sum(a_); }
                if (lane == 0) {
#pragma unroll
                    for (int c = 0; c < 4; ++c) if (gw + NGW * c < DFF) BIAS2[(size_t)b * DFF + gw + NGW * c] = acc[c]; }
            }
        }
        const float* aog = a.in[I_AOG]; const float* sog = a.in[I_SOG];
        for (int m = gw; m < MTOK; m += NGW) {
            float av[2][8], sv[2][8]; float assq = 0.f, sssq = 0.f;
#pragma unroll
            for (int i = 0; i < 2; ++i) { const int e0 = (i * 64 + lane) * 8, hh = e0 >> 7;
                const float l0 = LSE[((size_t)0 * MTOK + m) * 8 + hh], l1 = LSE[((size_t)1 * MTOK + m) * 8 + hh], l2 = LSE[((size_t)2 * MTOK + m) * 8 + hh];
                const float ml = fmaxf(l0, fmaxf(l1, l2)); float w0 = __expf(l0 - ml), w1 = __expf(l1 - ml), w2 = __expf(l2 - ml); const float iw = 1.f / (w0 + w1 + w2); w0 *= iw; w1 *= iw; w2 *= iw;
                const u32x4 x0 = *(const u32x4*)(ATTP + ((size_t)0 * MTOK + m) * AW + e0), x1 = *(const u32x4*)(ATTP + ((size_t)1 * MTOK + m) * AW + e0), x2 = *(const u32x4*)(ATTP + ((size_t)2 * MTOK + m) * AW + e0);
                av[i][0] = w0 * bflo(x0.x) + w1 * bflo(x1.x) + w2 * bflo(x2.x); av[i][1] = w0 * bfhi(x0.x) + w1 * bfhi(x1.x) + w2 * bfhi(x2.x);
                av[i][2] = w0 * bflo(x0.y) + w1 * bflo(x1.y) + w2 * bflo(x2.y); av[i][3] = w0 * bfhi(x0.y) + w1 * bfhi(x1.y) + w2 * bfhi(x2.y);
                av[i][4] = w0 * bflo(x0.z) + w1 * bflo(x1.z) + w2 * bflo(x2.z); av[i][5] = w0 * bfhi(x0.z) + w1 * bfhi(x1.z) + w2 * bfhi(x2.z);
                av[i][6] = w0 * bflo(x0.w) + w1 * bflo(x1.w) + w2 * bflo(x2.w); av[i][7] = w0 * bfhi(x0.w) + w1 * bfhi(x1.w) + w2 * bfhi(x2.w);
                const u32x4 y = *(const u32x4*)(SSMO + (size_t)m * SW + e0);
                sv[i][0] = bflo(y.x); sv[i][1] = bfhi(y.x); sv[i][2] = bflo(y.y); sv[i][3] = bfhi(y.y); sv[i][4] = bflo(y.z); sv[i][5] = bfhi(y.z); sv[i][6] = bflo(y.w); sv[i][7] = bfhi(y.w);
#pragma unroll
                for (int e = 0; e < 8; ++e) { assq += av[i][e] * av[i][e]; sssq += sv[i][e] * sv[i][e]; } }
            const float ra = rsqrtf(wave_sum(assq) * (1.f / AW) + EPS), rs = rsqrtf(wave_sum(sssq) * (1.f / SW) + EPS);
#pragma unroll
            for (int i = 0; i < 2; ++i) { const int e0 = (i * 64 + lane) * 8;
                const f32x4 ga0 = *(const f32x4*)(aog + e0), ga1 = *(const f32x4*)(aog + e0 + 4), gs0 = *(const f32x4*)(sog + e0), gs1 = *(const f32x4*)(sog + e0 + 4);
                u32x4 oa, os;
                oa.x = pk2(av[i][0] * ra * ga0[0], av[i][1] * ra * ga0[1]); oa.y = pk2(av[i][2] * ra * ga0[2], av[i][3] * ra * ga0[3]); oa.z = pk2(av[i][4] * ra * ga1[0], av[i][5] * ra * ga1[1]); oa.w = pk2(av[i][6] * ra * ga1[2], av[i][7] * ra * ga1[3]);
                os.x = pk2(sv[i][0] * rs * gs0[0], sv[i][1] * rs * gs0[1]); os.y = pk2(sv[i][2] * rs * gs0[2], sv[i][3] * rs * gs0[3]); os.z = pk2(sv[i][4] * rs * gs1[0], sv[i][5] * rs * gs1[1]); os.w = pk2(sv[i][6] * rs * gs1[2], sv[i][7] * rs * gs1[3]);
                *(u32x4*)(XN + (size_t)m * DM + e0) = oa; *(u32x4*)(XN + (size_t)m * DM + AW + e0) = os; }
        }
    }
    SEAM(7);
    if (IN(8)) {
        pg8::Gemm g{XN, WOUT, MTOK, DM, DM, DM, DM, 0, 0}; pg8::StaticOrder S; S.init(MTOK, DM, G, bid);
        pg8::EpiResN E{a.in[I_X], a.out, MOD + 2 * DM, a.in[I_N2G], MOD + 4 * DM, (bf16_t*)(ws + WS_H2), (float*)(ws + WS_SSQ)};
        pg8::gemm_phase<pg8::EpiResN>(lds, g, S, E);
    }
    SEAM(8);
    if (IN(10)) for (int rep = 0; rep < NREP(10); ++rep) {
        pg8::Gemm g{(const bf16_t*)(ws + WS_H2), WFF1, MTOK, DFF, DM, DM, DM, 0, 0}; pg8::StaticOrder S; S.init(MTOK, DFF, G, bid);
        pg8::EpiSqReluN E{ACT, (const float*)(ws + WS_SSQ), (const float*)(ws + WS_BIAS2)};
        pg8::gemm_phase<pg8::EpiSqReluN>(lds, g, S, E);
    }
    SEAM(10);
    if (IN(11)) {
        pg8::Gemm g{ACT, WFF2, MTOK, DM, DFF, DFF, DFF, 0, 0}; pg8::StaticOrder S; S.init(MTOK, DM, G, bid);
        pg8::EpiRes E{a.out, a.out, MOD + 5 * DM};
        pg8::gemm_phase<pg8::EpiRes>(lds, g, S, E);
    }
#if ONE_LAUNCH
    if (TPROBE_PH >= 0 && bid == 0 && tid == 0) {
        const unsigned long long tend = __builtin_amdgcn_s_memrealtime();
        tsl[NPH] = tend;
        int pa = TPROBE_PH, pb = TPROBE_PH + 1;
        if (TPROBE_PH == 100) { pa = 0; pb = 20; } if (TPROBE_PH == 101) { pa = 20; pb = 21; } if (TPROBE_PH == 102) { pa = 21; pb = 22; }
        if (TPROBE_PH == 10) pa = 9;
        const unsigned long long dt = tsl[pb] - tsl[pa];
        while (__builtin_amdgcn_s_memrealtime() - tend < dt * TPROBE_MULT) __builtin_amdgcn_s_sleep(8);
    }
#endif
#undef IN
#undef SEAM
}

extern "C" void kernel_launch(void* const* d_in, const int* in_sizes, int n_in, void* d_out, int out_size, void* d_ws, size_t ws_size, hipStream_t stream) {
    static int inited = 0;
    if (!inited) {
        if (n_in != 24 || ws_size < WS_END) { fprintf(stderr, "kernel_launch: unexpected inputs (n_in %d, ws %zu)\n", n_in, ws_size); inited = -1; return; }
        if (hipFuncSetAttribute((const void*)fwd_kernel, hipFuncAttributeMaxDynamicSharedMemorySize, LDS_BYTES) != hipSuccess) { fprintf(stderr, "kernel_launch: hipFuncSetAttribute failed\n"); inited = -1; return; }
        inited = 1;
    }
    if (inited < 0) return;
    (void)hipMemsetAsync((char*)d_ws + WS_CTL, 0, CTL_BYTES, stream);
    Args a{};
    for (int i = 0; i < 24; ++i) a.in[i] = (const float*)d_in[i];
    a.out = (float*)d_out; a.ws = (unsigned char*)d_ws;
    const int grid = 256;
#if ONE_LAUNCH
    a.ph_lo = 0; a.ph_hi = NPH;
    void* args[] = {&a};
    hipError_t e = hipLaunchCooperativeKernel((const void*)fwd_kernel, dim3(grid), dim3(512), args, LDS_BYTES, stream);
    if (e != hipSuccess) fprintf(stderr, "cooperative launch failed: %s\n", hipGetErrorString(e));
#else
    for (int ph = 0; ph < NPH; ++ph) { a.ph_lo = ph; a.ph_hi = ph + 1; hipLaunchKernelGGL(fwd_kernel, dim3(grid), dim3(512), LDS_BYTES, stream, a); }
#endif
}
```

```cpp
#include <hip/hip_runtime.h>
#include <hip/hip_cooperative_groups.h>
#include <cstdio>
#include <cstdint>
namespace cg = cooperative_groups;

#ifndef PH_MASK
#define PH_MASK 0xFFF
#endif
#ifndef DUP_MASK
#define DUP_MASK 0
#endif
#define NREP(k) ((((DUP_MASK) >> (k)) & 1) ? 2 : 1)
#ifndef TPROBE_PH
#define TPROBE_PH -1
#endif
#ifndef TPROBE_MULT
#define TPROBE_MULT 8
#endif
#ifndef ONE_LAUNCH
#define ONE_LAUNCH 1
#endif

#define LAS __attribute__((address_space(3)))
typedef unsigned short bf16_t;
typedef short bf16x8 __attribute__((ext_vector_type(8)));
typedef short s16x4 __attribute__((ext_vector_type(4)));
typedef float f32x4 __attribute__((ext_vector_type(4)));
typedef float f32x2 __attribute__((ext_vector_type(2)));
typedef unsigned u32x4 __attribute__((ext_vector_type(4)));
typedef unsigned u32x2 __attribute__((ext_vector_type(2)));
typedef __bf16 bf16x2_t __attribute__((ext_vector_type(2)));

constexpr int DM = 2048, BATCH = 4, SEQ = 8192, MTOK = BATCH * SEQ;
constexpr int AW = 1024, HD = 128, NH = 8, SW = 1024, NG = 64, GS = 16, NP = 64;
constexpr int INW = 4096, DFF = 8192, NMODC = 6 * DM;
constexpr int LS = 32;
constexpr int NSC = SEQ / LS;
constexpr int RPG = BATCH * NSC;
constexpr int KU = GS * LS;
constexpr int KA = KU + 128;
constexpr int NT = GS * LS;
constexpr int MSSM = NG * RPG;
constexpr float EPS = 1e-6f;
constexpr float QSCALE = 0.08838834764831845f * 1.4426950408889634f;

constexpr size_t MiB = 1u << 20;
constexpr size_t WS_CTL = 0, CTL_BYTES = 1 * MiB;
constexpr size_t WS_MODP = 1 * MiB;
constexpr size_t WS_MOD = 640 * 1024;
constexpr size_t WS_AL = 4 * MiB;
constexpr size_t WS_WIN = 8 * MiB;
constexpr size_t WS_WGLU = 24 * MiB;
constexpr size_t WS_WOUT = 26 * MiB;
constexpr size_t WS_WFF1 = 34 * MiB;
constexpr size_t WS_WFF2 = 66 * MiB;
constexpr size_t WS_TW = 98 * MiB;
constexpr size_t WS_WS = 138 * MiB;
constexpr size_t WS_XN = 160 * MiB;
constexpr size_t WS_ASSM = 288 * MiB;
constexpr size_t WS_SLOC = 368 * MiB;
constexpr size_t WS_QKV = 400 * MiB;
constexpr size_t WS_ATTP = 592 * MiB;
constexpr size_t WS_LSE = 784 * MiB;
constexpr size_t WS_YACT = 788 * MiB;
constexpr size_t WS_SSMO = 852 * MiB;
constexpr size_t WS_ACT = 288 * MiB;
constexpr size_t WS_H2 = 852 * MiB;
constexpr size_t WS_SSQ = 512 * 1024;
constexpr size_t WS_BIAS2 = 3 * MiB + 512 * 1024;
constexpr size_t WS_END = 980 * MiB;
static_assert(WS_TW + (size_t)NG * NT * KA * 2 <= WS_WS && WS_WS + (size_t)NG * 256 * KU * 2 <= WS_XN, "ws map");
static_assert(WS_ASSM + (size_t)MSSM * KA * 2 <= WS_SLOC && WS_SLOC + (size_t)MSSM * 128 * 4 <= WS_QKV, "ws map");
static_assert(WS_ACT + (size_t)MTOK * DFF * 2 <= WS_SSMO, "ws map");

constexpr int LDS_BYTES = 151552;
constexpr int NPH = 12;
constexpr int ATT_NIT = 3 * BATCH * NH * 64;
constexpr int PFX_BLOCKS = 32, ATT_EARLY_PER = 2;
constexpr int ATT_NIT5 = ATT_NIT - (256 - PFX_BLOCKS) * ATT_EARLY_PER;

__device__ __forceinline__ unsigned pk2(float lo, float hi) { f32x2 v = {lo, hi}; bf16x2_t b = __builtin_convertvector(v, bf16x2_t); return __builtin_bit_cast(unsigned, b); }
__device__ __forceinline__ float bflo(unsigned w) { return __uint_as_float(w << 16); }
__device__ __forceinline__ float bfhi(unsigned w) { return __uint_as_float(w & 0xffff0000u); }
__device__ __forceinline__ float wave_sum(float v) {
#pragma unroll
    for (int o = 1; o < 64; o <<= 1) v += __shfl_xor(v, o);
    return v;
}
#define LDS_WAIT() asm volatile("s_waitcnt lgkmcnt(0)" ::: "memory")

namespace pg8 {
#define PG8_LAS __attribute__((address_space(3)))
constexpr int BM = 256, BK = 64, HALF = 128, HTB = HALF * BK * 2, STAGE_BYTES = 8 * HTB, NXCD = 8, WGM = 4;
__host__ __device__ __forceinline__ int lds_byte(int r, int c) { const int st = (r >> 4) * 2 + (c >> 5), rr = r & 15, cc = c & 31, ob = rr * 64 + cc * 2; return st * 1024 + (ob ^ (((ob >> 9) & 1) << 5)); }
__host__ __device__ __forceinline__ void stage_rc(int b, int& R, int& C) { const int st = b / 1024, sb = b % 1024, swz = sb ^ (((sb >> 9) & 1) << 5); R = (st >> 1) * 16 + swz / 64; C = (st & 1) * 32 + (swz % 64) / 2; }
__host__ __device__ __forceinline__ int perm32(int rho) { const int n = rho >> 4, i = rho & 15; return 8 * (i >> 2) + 4 * n + (i & 3); }

struct Unit { int pm, pn; };
struct Gemm { const bf16_t* A; const bf16_t* Bt; int M, N, K, lda, ldb, bgrp; size_t bgstride; };

struct StaticOrder {
    int nM, nN, nwg, G, c;
    __device__ void init(int M, int N, int G_, int c_) { nM = M / BM; nN = N / BM; nwg = nM * nN; G = G_; c = c_; }
    __device__ bool next(int i, Unit& u) const {
        const long L = (long)i * G + c; if (L >= nwg) return false;
        int wgid = (int)L; { const int q = nwg / NXCD, r = nwg % NXCD, xcd = wgid % NXCD, off = wgid / NXCD; wgid = (xcd < r ? xcd * (q + 1) : r * (q + 1) + (xcd - r) * q) + off; }
        const int nig = WGM * nN, gid = wgid / nig, fm = gid * WGM, gsz = (nM - fm) < WGM ? (nM - fm) : WGM;
        u.pm = fm + ((wgid % nig) % gsz); u.pn = (wgid % nig) / gsz; return true;
    }
};

template <class Epi, bool HALFN = false>
__device__ __forceinline__ void gemm_phase(PG8_LAS unsigned char* lds, const Gemm g, const StaticOrder& S, const Epi& E) {
    const int tid = threadIdx.x, wid = __builtin_amdgcn_readfirstlane(tid >> 6), lane = tid & 63, wr = wid >> 2, wc = wid & 3, fr = lane & 15, fq = lane >> 4;
    const int K = g.K, nt = K / BK;
    unsigned voffA[2], voffB[2];
#pragma unroll
    for (int i = 0; i < 2; ++i) { int R, C; stage_rc(tid * 16 + i * 8192, R, C); const int Rb = Epi::PERM ? ((R & ~31) + perm32(R & 31)) : R;
        voffA[i] = (unsigned)(R * g.lda + C) * 2u; voffB[i] = (unsigned)(Rb * g.ldb + C) * 2u; }
    const size_t kstep = (size_t)(BK * 2);
    const size_t hstepA = (size_t)HALF * g.lda * 2, hstepB = (size_t)HALF * g.ldb * 2;
    const size_t tstepA = 2 * hstepA, tstepB = 2 * hstepB;
    const unsigned ldsw = (unsigned)wid * 1024u;
    const int aoff = lds_byte(wr * 64 + fr, fq * 8), boff = lds_byte(wc * 32 + fr, fq * 8);
#define PG8_SA(b, h) (((b) * 2 + (h)) * HTB)
#define PG8_SB(b, h) ((4 + (b) * 2 + (h)) * HTB)
#define PG8_STAGE(bufoff, gbase, voff) do { _Pragma("unroll") for (int _i = 0; _i < 2; ++_i) \
        __builtin_amdgcn_global_load_lds((const unsigned*)((const char*)(gbase) + (voff)[_i]), (PG8_LAS unsigned*)(lds + (bufoff) + ldsw + _i * 8192), 16, 0, 0); } while (0)
#define PG8_LDA(dst, b, h) do { _Pragma("unroll") for (int m = 0; m < 4; ++m) _Pragma("unroll") for (int k = 0; k < 2; ++k) dst[m][k] = *(const PG8_LAS bf16x8*)(lds + PG8_SA(b, h) + aoff + m * 2048 + k * 1024); } while (0)
#define PG8_LDB(dst, b, h) do { _Pragma("unroll") for (int n = 0; n < 2; ++n) _Pragma("unroll") for (int k = 0; k < 2; ++k) dst[n][k] = *(const PG8_LAS bf16x8*)(lds + PG8_SB(b, h) + boff + n * 2048 + k * 1024); } while (0)
#define PG8_MMA(ai, bj, At, Bt) do { __builtin_amdgcn_s_setprio(1); _Pragma("unroll") for (int m = 0; m < 4; ++m) _Pragma("unroll") for (int n = 0; n < 2; ++n) _Pragma("unroll") for (int k = 0; k < 2; ++k) \
        acc[ai][bj][m][n] = __builtin_amdgcn_mfma_f32_16x16x32_bf16(Bt[n][k], At[m][k], acc[ai][bj][m][n], 0, 0, 0); __builtin_amdgcn_s_setprio(0); } while (0)
#define PG8_WAIT_V(n) asm volatile("s_waitcnt vmcnt(" #n ")" ::: "memory")
#define PG8_WAIT_L(n) asm volatile("s_waitcnt lgkmcnt(" #n ")" ::: "memory")
#define PG8_BAR __builtin_amdgcn_s_barrier()
#define PG8_SCHED __builtin_amdgcn_sched_barrier(0)
#define PG8_BBASE(u) ((const char*)g.Bt + (size_t)(u).pn * tstepB + (g.bgrp ? (size_t)((u).pm / g.bgrp) * g.bgstride : (size_t)0))
    Unit cur, nxt; int ui = 0;
    if (!S.next(0, cur)) return;
    f32x4 acc[2][2][4][2];
#pragma unroll
    for (int a = 0; a < 2; ++a)
#pragma unroll
        for (int b = 0; b < 2; ++b)
#pragma unroll
            for (int m = 0; m < 4; ++m)
#pragma unroll
                for (int n = 0; n < 2; ++n) acc[a][b][m][n] = (f32x4){0.f, 0.f, 0.f, 0.f};
    bf16x8 At[4][2], B0[2][2], B1[2][2];
    const char* cA = (const char*)g.A + (size_t)cur.pm * tstepA; const char* cB = PG8_BBASE(cur);
    PG8_STAGE(PG8_SB(0, 0), cB, voffB); PG8_STAGE(PG8_SB(0, 1), cB + hstepB, voffB); PG8_STAGE(PG8_SA(0, 0), cA, voffA); PG8_STAGE(PG8_SA(0, 1), cA + hstepA, voffA);
    if (wr == 1) PG8_BAR;
    PG8_WAIT_V(2); PG8_BAR;
    PG8_STAGE(PG8_SB(1, 0), cB + kstep, voffB); PG8_STAGE(PG8_SA(1, 0), cA + kstep, voffA); PG8_STAGE(PG8_SB(1, 1), cB + hstepB + kstep, voffB);
    PG8_WAIT_V(6); PG8_BAR;
    for (;;) {
        const bool has_next = S.next(ui + 1, nxt);
        const char* nA = has_next ? (const char*)g.A + (size_t)nxt.pm * tstepA : cA; const char* nB = has_next ? PG8_BBASE(nxt) : cB;
        for (int t = 0; t < nt; t += 2) {
            const bool last = (t == nt - 2);
            const char* a1 = cA + (size_t)(t + 1) * kstep;
            const char* a2 = last ? nA : cA + (size_t)(t + 2) * kstep; const char* b2 = last ? nB : cB + (size_t)(t + 2) * kstep;
            const char* a3 = a2 + kstep; const char* b3 = b2 + kstep;
            PG8_LDB(B0, 0, 0); PG8_LDB(B1, 0, 1); PG8_SCHED; PG8_LDA(At, 0, 0); PG8_STAGE(PG8_SA(1, 1), a1 + hstepA, voffA);
            PG8_WAIT_V(8); PG8_WAIT_L(0); PG8_BAR; PG8_MMA(0, 0, At, B0); if constexpr (!HALFN) PG8_MMA(0, 1, At, B1); PG8_BAR; PG8_SCHED;
            PG8_LDA(At, 0, 1); PG8_STAGE(PG8_SB(0, 0), b2, voffB); PG8_STAGE(PG8_SB(0, 1), b2 + hstepB, voffB); PG8_STAGE(PG8_SA(0, 0), a2, voffA);
            PG8_WAIT_V(8); PG8_WAIT_L(0); PG8_BAR; PG8_MMA(1, 0, At, B0); if constexpr (!HALFN) PG8_MMA(1, 1, At, B1); PG8_BAR; PG8_SCHED;
            PG8_LDB(B0, 1, 0); PG8_LDB(B1, 1, 1); PG8_SCHED; PG8_LDA(At, 1, 0); PG8_STAGE(PG8_SA(0, 1), a2 + hstepA, voffA);
            PG8_WAIT_V(8); PG8_WAIT_L(0); PG8_BAR; PG8_MMA(0, 0, At, B0); if constexpr (!HALFN) PG8_MMA(0, 1, At, B1); PG8_BAR; PG8_SCHED;
            PG8_LDA(At, 1, 1); PG8_STAGE(PG8_SB(1, 0), b3, voffB); PG8_STAGE(PG8_SB(1, 1), b3 + hstepB, voffB); PG8_STAGE(PG8_SA(1, 0), a3, voffA);
            PG8_WAIT_V(8); PG8_WAIT_L(0); PG8_BAR; PG8_MMA(1, 0, At, B0); if constexpr (!HALFN) PG8_MMA(1, 1, At, B1); PG8_BAR; PG8_SCHED;
        }
        if (wr == 0) PG8_BAR;
        E(acc, cur, wr, wc, fr, fq);
        if (!has_next) break;
#pragma unroll
        for (int a = 0; a < 2; ++a)
#pragma unroll
            for (int b = 0; b < 2; ++b)
#pragma unroll
                for (int m = 0; m < 4; ++m)
#pragma unroll
                    for (int n = 0; n < 2; ++n) acc[a][b][m][n] = (f32x4){0.f, 0.f, 0.f, 0.f};
        cur = nxt; cA = nA; cB = nB; ++ui;
        if (wr == 1) PG8_BAR;
    }
    PG8_WAIT_V(0);
    PG8_BAR;
#undef PG8_SA
#undef PG8_SB
#undef PG8_STAGE
#undef PG8_LDA
#undef PG8_LDB
#undef PG8_MMA
#undef PG8_WAIT_V
#undef PG8_WAIT_L
#undef PG8_BAR
#undef PG8_SCHED
#undef PG8_BBASE
}

__device__ __forceinline__ u32x4 pack8(const f32x4 v0, const f32x4 v1) { u32x4 w; w.x = pk2(v0[0], v0[1]); w.y = pk2(v0[2], v0[3]); w.z = pk2(v1[0], v1[1]); w.w = pk2(v1[2], v1[3]); return w; }

struct EpiProj {
    static constexpr bool PERM = true;
    bf16_t* QKV; bf16_t* ASSM; const float* qg; const float* kg; PG8_LAS float* red;
    __device__ __forceinline__ void operator()(const f32x4 (&acc)[2][2][4][2], const Unit& u, int wr, int wc, int fr, int fq) const {
        const int row0 = u.pm * BM + wr * 64 + fr;
        if (u.pn < 8) {
#pragma unroll
            for (int ai = 0; ai < 2; ++ai)
#pragma unroll
                for (int m = 0; m < 4; ++m)
#pragma unroll
                    for (int bj = 0; bj < 2; ++bj) { const f32x4 v0 = acc[ai][bj][m][0], v1 = acc[ai][bj][m][1];
                        float ss = (v0[0] * v0[0] + v0[1] * v0[1]) + (v0[2] * v0[2] + v0[3] * v0[3]) + (v1[0] * v1[0] + v1[1] * v1[1]) + (v1[2] * v1[2] + v1[3] * v1[3]);
                        ss += __shfl_xor(ss, 16); ss += __shfl_xor(ss, 32);
                        if (fq == 0) red[((ai * HALF + wr * 64 + m * 16 + fr) * 2 + bj) * 4 + wc] = ss; }
            asm volatile("s_waitcnt lgkmcnt(0)" ::: "memory"); __builtin_amdgcn_s_barrier(); asm volatile("" ::: "memory");
            const float* gp = (u.pn < 4) ? qg : kg; const float gsc = (u.pn < 4) ? QSCALE : 1.0f;
            f32x4 g0 = *(const f32x4*)(gp + wc * 32 + 8 * fq), g1 = *(const f32x4*)(gp + wc * 32 + 8 * fq + 4); g0 = g0 * gsc; g1 = g1 * gsc;
            const int col0 = u.pn * BM + wc * 32 + 8 * fq;
#pragma unroll
            for (int ai = 0; ai < 2; ++ai)
#pragma unroll
                for (int m = 0; m < 4; ++m) { bf16_t* rowp = QKV + (size_t)(row0 + ai * HALF + m * 16) * 3072 + col0;
#pragma unroll
                    for (int bj = 0; bj < 2; ++bj) { const f32x4 pr = *(const PG8_LAS f32x4*)(red + ((ai * HALF + wr * 64 + m * 16 + fr) * 2 + bj) * 4);
                        const float rstd = rsqrtf(((pr[0] + pr[1]) + (pr[2] + pr[3])) * (1.f / HD) + EPS);
                        *(u32x4*)(rowp + bj * HALF) = pack8(acc[ai][bj][m][0] * rstd * g0, acc[ai][bj][m][1] * rstd * g1); } }
        } else if (u.pn < 12) {
            const int col0 = u.pn * BM + wc * 32 + 8 * fq;
#pragma unroll
            for (int ai = 0; ai < 2; ++ai)
#pragma unroll
                for (int m = 0; m < 4; ++m) { bf16_t* rowp = QKV + (size_t)(row0 + ai * HALF + m * 16) * 3072 + col0;
#pragma unroll
                    for (int bj = 0; bj < 2; ++bj) *(u32x4*)(rowp + bj * HALF) = pack8(acc[ai][bj][m][0], acc[ai][bj][m][1]); }
        } else {
#pragma unroll
            for (int ai = 0; ai < 2; ++ai)
#pragma unroll
                for (int m = 0; m < 4; ++m) { const int row = row0 + ai * HALF + m * 16; const int b = row / SEQ, tt = row % SEQ, sc = tt / LS, s = tt % LS;
#pragma unroll
                    for (int bj = 0; bj < 2; ++bj) { const int colu = (u.pn - 12) * BM + bj * HALF + wc * 32 + 8 * fq; const int gg = colu >> 4, j0 = colu & 15;
                        bf16_t* dst = ASSM + ((size_t)gg * RPG + (size_t)b * NSC + sc) * KA + s * 16 + j0;
                        *(u32x4*)dst = pack8(acc[ai][bj][m][0], acc[ai][bj][m][1]); } }
        }
    }
};
struct EpiSloc {
    static constexpr bool PERM = false;
    float* SLOC;
    __device__ __forceinline__ void operator()(const f32x4 (&acc)[2][2][4][2], const Unit& u, int wr, int wc, int fr, int fq) const {
        const int row0 = u.pm * BM + wr * 64 + fr, col0 = wc * 32 + 4 * fq;
#pragma unroll
        for (int ai = 0; ai < 2; ++ai)
#pragma unroll
            for (int m = 0; m < 4; ++m) { float* rowp = SLOC + (size_t)(row0 + ai * HALF + m * 16) * 128 + col0;
#pragma unroll
                for (int n = 0; n < 2; ++n) *(f32x4*)(rowp + n * 16) = acc[ai][0][m][n]; }
    }
};
__device__ __forceinline__ float gelu_tanh(float v) {
    const float z = 0.7978845608028654f * (v + 0.044715f * v * v * v);
    const float e = __expf(2.f * z);
    const float th = 1.f - 2.f / (1.f + e);
    return 0.5f * v * (1.f + th);
}
struct EpiY {
    static constexpr bool PERM = true;
    const bf16_t* ASSM; bf16_t* YACT; const float* dskip;
    __device__ __forceinline__ void operator()(const f32x4 (&acc)[2][2][4][2], const Unit& u, int wr, int wc, int fr, int fq) const {
        const int row0 = u.pm * BM + wr * 64 + fr;
        const int cb = u.pn * BM + wc * 32 + 8 * fq, i0 = cb & 15;
        u32x4 uwq[8][2]; f32x4 dq[8][2];
#define EY_LOAD(g) do { const int R_ = row0 + ((g) >> 2) * HALF + ((g) & 3) * 16; const int gg_ = R_ / RPG; \
            _Pragma("unroll") for (int bj = 0; bj < 2; ++bj) uwq[g][bj] = *(const u32x4*)(ASSM + (size_t)R_ * KA + cb + bj * HALF); \
            dq[g][0] = *(const f32x4*)(dskip + gg_ * 16 + i0); dq[g][1] = *(const f32x4*)(dskip + gg_ * 16 + i0 + 4); } while (0)
        EY_LOAD(0); EY_LOAD(1);
#pragma unroll
        for (int g = 0; g < 8; ++g) { if (g + 2 < 8) EY_LOAD(g + 2);
            asm volatile("" ::: "memory");
            const int ai = g >> 2, m = g & 3; const int R = row0 + ai * HALF + m * 16; const int gg = R / RPG, rem = R % RPG, b = rem / NSC, sc = rem % NSC;
#pragma unroll
            for (int bj = 0; bj < 2; ++bj) { const int c = cb + bj * HALF; const int t = c >> 4;
                const u32x4 uw = uwq[g][bj]; const f32x4 d0 = dq[g][0], d1 = dq[g][1];
                f32x4 v0 = acc[ai][bj][m][0], v1 = acc[ai][bj][m][1];
                v0[0] += d0[0] * bflo(uw.x); v0[1] += d0[1] * bfhi(uw.x); v0[2] += d0[2] * bflo(uw.y); v0[3] += d0[3] * bfhi(uw.y);
                v1[0] += d1[0] * bflo(uw.z); v1[1] += d1[1] * bfhi(uw.z); v1[2] += d1[2] * bflo(uw.w); v1[3] += d1[3] * bfhi(uw.w);
#pragma unroll
                for (int e = 0; e < 4; ++e) { v0[e] = gelu_tanh(v0[e]); v1[e] = gelu_tanh(v1[e]); }
                const size_t tok = (size_t)b * SEQ + (size_t)sc * LS + t;
                *(u32x4*)(YACT + tok * SW + gg * 16 + i0) = pack8(v0, v1); }
            asm volatile("" ::: "memory"); }
#undef EY_LOAD
    }
};
struct EpiGlu {
    static constexpr bool PERM = true;
    const bf16_t* YACT; bf16_t* SSMO; const float* bglu;
    __device__ __forceinline__ void operator()(const f32x4 (&acc)[2][2][4][2], const Unit& u, int wr, int wc, int fr, int fq) const {
        const int row0 = u.pm * BM + wr * 64 + fr, col0 = u.pn * BM + wc * 32 + 8 * fq;
        f32x4 bq[2][2];
#pragma unroll
        for (int bj = 0; bj < 2; ++bj) { bq[bj][0] = *(const f32x4*)(bglu + col0 + bj * HALF); bq[bj][1] = *(const f32x4*)(bglu + col0 + bj * HALF + 4); }
        u32x4 ywq[8][2];
#define EG_LOAD(g) do { const size_t ro_ = (size_t)(row0 + ((g) >> 2) * HALF + ((g) & 3) * 16) * SW + col0; \
            _Pragma("unroll") for (int bj = 0; bj < 2; ++bj) ywq[g][bj] = *(const u32x4*)(YACT + ro_ + bj * HALF); } while (0)
        EG_LOAD(0); EG_LOAD(1);
#pragma unroll
        for (int g = 0; g < 8; ++g) { if (g + 2 < 8) EG_LOAD(g + 2);
            asm volatile("" ::: "memory");
            const int ai = g >> 2, m = g & 3; const size_t ro = (size_t)(row0 + ai * HALF + m * 16) * SW + col0;
#pragma unroll
            for (int bj = 0; bj < 2; ++bj) { const u32x4 yw = ywq[g][bj];
                f32x4 v0 = acc[ai][bj][m][0] + bq[bj][0], v1 = acc[ai][bj][m][1] + bq[bj][1];
#pragma unroll
                for (int e = 0; e < 4; ++e) { v0[e] = 1.f / (1.f + __expf(-v0[e])); v1[e] = 1.f / (1.f + __expf(-v1[e])); }
                v0[0] *= bflo(yw.x); v0[1] *= bfhi(yw.x); v0[2] *= bflo(yw.y); v0[3] *= bfhi(yw.y);
                v1[0] *= bflo(yw.z); v1[1] *= bfhi(yw.z); v1[2] *= bflo(yw.w); v1[3] *= bfhi(yw.w);
                *(u32x4*)(SSMO + ro + bj * HALF) = pack8(v0, v1); }
            asm volatile("" ::: "memory"); }
#undef EG_LOAD
    }
};
struct EpiRes {
    static constexpr bool PERM = false;
    const float* base; float* out; const float* gate;
    __device__ __forceinline__ void operator()(const f32x4 (&acc)[2][2][4][2], const Unit& u, int wr, int wc, int fr, int fq) const {
        const int row0 = u.pm * BM + wr * 64 + fr, col0 = u.pn * BM + wc * 32 + 4 * fq;
        const int b = (u.pm * BM) / SEQ;
        f32x4 gv[2][2];
#pragma unroll
        for (int bj = 0; bj < 2; ++bj)
#pragma unroll
            for (int n = 0; n < 2; ++n) gv[bj][n] = *(const f32x4*)(gate + (size_t)b * NMODC + col0 + bj * HALF + n * 16);
        f32x4 bs[8][2][2];
#define ER_LOAD(g) do { const size_t off_ = (size_t)(row0 + ((g) >> 2) * HALF + ((g) & 3) * 16) * DM + col0; \
            _Pragma("unroll") for (int bj = 0; bj < 2; ++bj) _Pragma("unroll") for (int n = 0; n < 2; ++n) bs[g][bj][n] = *(const f32x4*)(base + off_ + bj * HALF + n * 16); } while (0)
        ER_LOAD(0); ER_LOAD(1);
#pragma unroll
        for (int g = 0; g < 8; ++g) { if (g + 2 < 8) ER_LOAD(g + 2);
            asm volatile("" ::: "memory");
            const int ai = g >> 2, m = g & 3; const size_t off = (size_t)(row0 + ai * HALF + m * 16) * DM + col0;
#pragma unroll
            for (int bj = 0; bj < 2; ++bj)
#pragma unroll
                for (int n = 0; n < 2; ++n) *(f32x4*)(out + off + bj * HALF + n * 16) = bs[g][bj][n] + gv[bj][n] * acc[ai][bj][m][n];
            asm volatile("" ::: "memory"); }
#undef ER_LOAD
    }
};
struct EpiSqRelu {
    static constexpr bool PERM = true;
    bf16_t* O;
    __device__ __forceinline__ void operator()(const f32x4 (&acc)[2][2][4][2], const Unit& u, int wr, int wc, int fr, int fq) const {
        const int row0 = u.pm * BM + wr * 64 + fr, col0 = u.pn * BM + wc * 32 + 8 * fq;
#pragma unroll
        for (int ai = 0; ai < 2; ++ai)
#pragma unroll
            for (int m = 0; m < 4; ++m) { bf16_t* rowp = O + (size_t)(row0 + ai * HALF + m * 16) * DFF + col0;
#pragma unroll
                for (int bj = 0; bj < 2; ++bj) { f32x4 v0 = acc[ai][bj][m][0], v1 = acc[ai][bj][m][1];
#pragma unroll
                    for (int e = 0; e < 4; ++e) { const float a0 = fmaxf(v0[e], 0.f), a1 = fmaxf(v1[e], 0.f); v0[e] = a0 * a0; v1[e] = a1 * a1; }
                    *(u32x4*)(rowp + bj * HALF) = pack8(v0, v1); } }
    }
};

struct EpiResN {
    static constexpr bool PERM = true;
    const float* base; float* out; const float* gate; const float* n2g; const float* sc2; bf16_t* H2; float* SSQ;
    __device__ __forceinline__ void operator()(const f32x4 (&acc)[2][2][4][2], const Unit& u, int wr, int wc, int fr, int fq) const {
        const int row0 = u.pm * BM + wr * 64 + fr, col0 = u.pn * BM + wc * 32 + 8 * fq;
        const int b = (u.pm * BM) / SEQ;
        f32x4 gv[2][2], gn[2][2];
#pragma unroll
        for (int bj = 0; bj < 2; ++bj)
#pragma unroll
            for (int n = 0; n < 2; ++n) { const int c = col0 + bj * HALF + 4 * n; gv[bj][n] = *(const f32x4*)(gate + (size_t)b * NMODC + c);
                gn[bj][n] = *(const f32x4*)(n2g + c) * (*(const f32x4*)(sc2 + (size_t)b * NMODC + c) + 1.0f); }
        f32x4 bs[8][2][2];
#define ER_LOAD(g) do { const size_t off_ = (size_t)(row0 + ((g) >> 2) * HALF + ((g) & 3) * 16) * DM + col0; \
            _Pragma("unroll") for (int bj = 0; bj < 2; ++bj) _Pragma("unroll") for (int n = 0; n < 2; ++n) bs[g][bj][n] = *(const f32x4*)(base + off_ + bj * HALF + 4 * n); } while (0)
        ER_LOAD(0); ER_LOAD(1);
#pragma unroll
        for (int g = 0; g < 8; ++g) { if (g + 2 < 8) ER_LOAD(g + 2);
            asm volatile("" ::: "memory");
            const int ai = g >> 2, m = g & 3; const int row = row0 + ai * HALF + m * 16; const size_t off = (size_t)row * DM + col0; float ss = 0.f;
#pragma unroll
            for (int bj = 0; bj < 2; ++bj) { f32x4 x1[2];
#pragma unroll
                for (int n = 0; n < 2; ++n) { x1[n] = bs[g][bj][n] + gv[bj][n] * acc[ai][bj][m][n];
                    *(f32x4*)(out + off + bj * HALF + 4 * n) = x1[n]; ss += (x1[n][0] * x1[n][0] + x1[n][1] * x1[n][1]) + (x1[n][2] * x1[n][2] + x1[n][3] * x1[n][3]); }
                *(u32x4*)(H2 + off + bj * HALF) = pack8(x1[0] * gn[bj][0], x1[1] * gn[bj][1]); }
            ss += __shfl_xor(ss, 16); ss += __shfl_xor(ss, 32);
            if (fq == 0) atomicAdd(SSQ + row, ss);
            asm volatile("" ::: "memory"); }
#undef ER_LOAD
    }
};
struct EpiSqReluN {
    static constexpr bool PERM = true;
    bf16_t* O; const float* SSQ; const float* bias2;
    __device__ __forceinline__ void operator()(const f32x4 (&acc)[2][2][4][2], const Unit& u, int wr, int wc, int fr, int fq) const {
        const int row0 = u.pm * BM + wr * 64 + fr, col0 = u.pn * BM + wc * 32 + 8 * fq;
        const int b = (u.pm * BM) / SEQ;
        f32x4 bv[2][2];
#pragma unroll
        for (int bj = 0; bj < 2; ++bj)
#pragma unroll
            for (int n = 0; n < 2; ++n) bv[bj][n] = *(const f32x4*)(bias2 + (size_t)b * DFF + col0 + bj * HALF + 4 * n);
#pragma unroll
        for (int ai = 0; ai < 2; ++ai)
#pragma unroll
            for (int m = 0; m < 4; ++m) { const int row = row0 + ai * HALF + m * 16; const float rstd = rsqrtf(SSQ[row] * (1.f / DM) + EPS);
                bf16_t* rowp = O + (size_t)row * DFF + col0;
#pragma unroll
                for (int bj = 0; bj < 2; ++bj) { f32x4 v0 = acc[ai][bj][m][0] * rstd + bv[bj][0], v1 = acc[ai][bj][m][1] * rstd + bv[bj][1];
#pragma unroll
                    for (int e = 0; e < 4; ++e) { const float a0 = fmaxf(v0[e], 0.f), a1 = fmaxf(v1[e], 0.f); v0[e] = a0 * a0; v1[e] = a1 * a1; }
                    *(u32x4*)(rowp + bj * HALF) = pack8(v0, v1); } }
    }
};
}

struct Args { const float* in[24]; float* out; unsigned char* ws; int ph_lo, ph_hi; };
enum { I_X = 0, I_C, I_WADA, I_BADA, I_N1G, I_WIN, I_QG, I_KG, I_LRE, I_LIM, I_LSTEP, I_BRE, I_BIM, I_CRE, I_CIM, I_DSKIP, I_WGLU, I_BGLU, I_AOG, I_SOG, I_WOUT, I_N2G, I_WFF1, I_WFF2 };

__device__ __forceinline__ void p0_mod_item(const float* c, const float* w_ada, const float* b_ada, float* MOD, LAS unsigned char* lds, int item, int tid, int wave, int lane) {
    const int cgi = item % 48, ks = item / 48;
    LAS float* sc = (LAS float*)lds; LAS float* red = (LAS float*)(lds + 4096);
    __syncthreads();
    { const int b = tid >> 7, kk = tid & 127; const float v = c[b * DM + ks * 128 + kk]; sc[tid] = v / (1.f + __expf(-v)); }
    __syncthreads();
    f32x4 acc[4];
#pragma unroll
    for (int b = 0; b < 4; ++b) acc[b] = (f32x4){0.f, 0.f, 0.f, 0.f};
    const float* wp = w_ada + (size_t)(ks * 128 + wave * 16) * NMODC + cgi * 256 + lane * 4;
    f32x4 w[16];
#pragma unroll
    for (int kk = 0; kk < 16; ++kk) w[kk] = *(const f32x4*)(wp + (size_t)kk * NMODC);
#pragma unroll
    for (int kk = 0; kk < 16; ++kk) {
#pragma unroll
        for (int b = 0; b < 4; ++b) { const float s_ = sc[b * 128 + wave * 16 + kk]; acc[b] += w[kk] * s_; }
    }
#pragma unroll
    for (int b = 0; b < 4; ++b) *(LAS f32x4*)(red + (wave * 4 + b) * 256 + lane * 4) = acc[b];
    __syncthreads();
    for (int u = tid; u < 1024; u += 512) { const int b = u >> 8, col = u & 255; float s_ = 0.f;
#pragma unroll
        for (int w_ = 0; w_ < 8; ++w_) s_ += red[(w_ * 4 + b) * 256 + col];
        if (ks == 0) s_ += b_ada[cgi * 256 + col];
        atomicAdd(MOD + (size_t)b * NMODC + cgi * 256 + col, s_); }
}

__device__ __forceinline__ void p0_transpose_item(const float* W, int K, int N, bf16_t* WT, LAS float* scr, int item, int lane) {
    const int nblk = N / 32, kb = item / nblk, nb = item % nblk, k0 = 64 * kb, n0 = 32 * nb;
    { const int c4 = (lane & 7) * 4, kr = lane >> 3;
      f32x4 v[8];
#pragma unroll
      for (int i = 0; i < 8; ++i) v[i] = *(const f32x4*)(W + (size_t)(k0 + 8 * i + kr) * N + n0 + c4);
#pragma unroll
      for (int i = 0; i < 8; ++i) { LAS float* d = scr + (8 * i + kr) * 33 + c4; d[0] = v[i][0]; d[1] = v[i][1]; d[2] = v[i][2]; d[3] = v[i][3]; } }
    LDS_WAIT(); asm volatile("" ::: "memory");
    const int c = lane & 7;
#pragma unroll
    for (int j = 0; j < 4; ++j) { const int n = (lane >> 3) + 8 * j; const LAS float* s = scr + (8 * c) * 33 + n;
        u32x4 o; o.x = pk2(s[0 * 33], s[1 * 33]); o.y = pk2(s[2 * 33], s[3 * 33]); o.z = pk2(s[4 * 33], s[5 * 33]); o.w = pk2(s[6 * 33], s[7 * 33]);
        *(u32x4*)(WT + (size_t)(n0 + n) * K + k0 + 8 * c) = o; }
    LDS_WAIT(); asm volatile("" ::: "memory");
}

__device__ __forceinline__ void p0_ssm_item(const Args& a, LAS unsigned char* lds, int item, int tid) {
    const int g = item >> 2, q = item & 3;
    unsigned char* ws = a.ws;
    bf16_t* TW = (bf16_t*)(ws + WS_TW); bf16_t* WSm = (bf16_t*)(ws + WS_WS); float* AL = (float*)(ws + WS_AL);
    LAS float* apr = (LAS float*)lds;
    LAS float* api = apr + (LS + 1) * 64;
    LAS float* bbr = api + (LS + 1) * 64;
    LAS float* bbi = bbr + 1024;
    LAS float* ccr = bbi + 1024;
    LAS float* cci = ccr + 1024;
    LAS float* Kt8 = cci + 1024;
    LAS float* Xr = Kt8 + 8 * 260;
    LAS float* Xi = Xr + 8192;
    const float* lam_re = a.in[I_LRE]; const float* lam_im = a.in[I_LIM];
    __syncthreads();
    const float st = expf(a.in[I_LSTEP][g]);
    for (int u = tid; u < (LS + 1) * 64; u += 512) { const int tau = u >> 6, p = u & 63;
        const float lr = lam_re[g * 64 + p] * st, li = lam_im[g * 64 + p] * st;
        const float mag = __expf(lr * (float)tau);
        float rev = li * (float)tau * 0.15915494309189535f; rev -= rintf(rev);
        apr[u] = mag * __builtin_amdgcn_cosf(rev); api[u] = mag * __builtin_amdgcn_sinf(rev); }
    for (int u = tid; u < 1024; u += 512) { const int i = u >> 6, p = u & 63; ccr[u] = a.in[I_CRE][(g * 16 + i) * 64 + p]; cci[u] = a.in[I_CIM][(g * 16 + i) * 64 + p]; }
    __syncthreads();
    for (int u = tid; u < 1024; u += 512) { const int p = u >> 4, j = u & 15;
        const float lr = lam_re[g * 64 + p], li = lam_im[g * 64 + p];
        const float x = apr[64 + p] - 1.f, y = api[64 + p];
        const float den = 1.f / (lr * lr + li * li);
        const float cr_ = (x * lr + y * li) * den, ci_ = (y * lr - x * li) * den;
        const float br = a.in[I_BRE][(g * 64 + p) * 16 + j], bi = a.in[I_BIM][(g * 64 + p) * 16 + j];
        bbr[u] = cr_ * br - ci_ * bi; bbi[u] = cr_ * bi + ci_ * br; }
    __syncthreads();
    for (int u = tid; u < 8192; u += 512) { const int tl = u >> 10, p = (u >> 4) & 63, j = u & 15; const int tau = 8 * q + tl;
        const float ar = apr[tau * 64 + p], ai = api[tau * 64 + p]; const float br = bbr[p * 16 + j], bi = bbi[p * 16 + j];
        Xr[u] = ar * br - ai * bi; Xi[u] = ar * bi + ai * br; }
    __syncthreads();
    for (int u = tid; u < 2048; u += 512) { const int tl = u >> 8, i = (u >> 4) & 15, j = u & 15; float sacc = 0.f;
#pragma unroll 8
        for (int p = 0; p < 64; ++p) sacc += ccr[i * 64 + p] * Xr[(tl * 64 + p) * 16 + j] - cci[i * 64 + p] * Xi[(tl * 64 + p) * 16 + j];
        Kt8[tl * 260 + (u & 255)] = sacc; }
    __syncthreads();
    LAS unsigned* Kp = (LAS unsigned*)(Xi + 8192);
    for (int u = tid; u < 1024; u += 512) { const int tl = u >> 7, e = u & 127; Kp[tl * 132 + e] = pk2(Kt8[tl * 260 + 2 * e], Kt8[tl * 260 + 2 * e + 1]); }
    __syncthreads();
    constexpr int RQ = NT / 4, PCS = KA / 8, UPC = KU / 8;
    for (int u = tid; u < 8 * 2 * LS * 16 * 2; u += 512) {
        const int jh = u & 1, tl = (u >> 1) & 7, i = (u >> 4) & 15, t = (u >> 8) & (LS - 1), up = u >> 13; const int d = 8 * q + tl;
        const int sidx = up ? t + d : t - d;
        const bool valid = up ? (d >= 1 && sidx < LS) : (sidx >= 0);
        if (valid) {
            unsigned w[4];
            if (!up) { const u32x4 kq = *(const LAS u32x4*)(Kp + tl * 132 + i * 8 + 4 * jh); w[0] = kq.x; w[1] = kq.y; w[2] = kq.z; w[3] = kq.w; }
            else { w[0] = w[1] = w[2] = w[3] = 0u; }
            *(u32x4*)(TW + ((size_t)(g * NT + t * 16 + i)) * KA + (2 * sidx + jh) * 8) = (u32x4){w[0], w[1], w[2], w[3]};
        }
    }
    for (int u = tid; u < RQ * (PCS - UPC); u += 512) {
        const int r = q * RQ + u / (PCS - UPC), pc = UPC + u % (PCS - UPC); const int t = r >> 4, i = r & 15;
        unsigned w[4];
        const int pp = (pc - UPC) * 8, p0 = pp & 63, isim = pp >> 6;
#pragma unroll
        for (int e2 = 0; e2 < 4; ++e2) { float v[2];
#pragma unroll
            for (int h = 0; h < 2; ++h) { const int p = p0 + 2 * e2 + h; const float ar = apr[(t + 1) * 64 + p], ai = api[(t + 1) * 64 + p];
                const float zr = ccr[i * 64 + p] * ar - cci[i * 64 + p] * ai, zi = ccr[i * 64 + p] * ai + cci[i * 64 + p] * ar; v[h] = isim ? -zi : zr; }
            w[e2] = pk2(v[0], v[1]); }
        *(u32x4*)(TW + ((size_t)(g * NT + r)) * KA + pc * 8) = (u32x4){w[0], w[1], w[2], w[3]};
    }
    for (int u = tid; u < 64 * UPC; u += 512) {
        const int pr = q * 64 + u / UPC, pc = u % UPC; const int s = pc >> 1, j0 = (pc & 1) * 8;
        unsigned w[4];
        if (q < 2) { const int p = pr & 63; const float ar = apr[(LS - 1 - s) * 64 + p], ai = api[(LS - 1 - s) * 64 + p];
#pragma unroll
            for (int e2 = 0; e2 < 4; ++e2) { float v[2];
#pragma unroll
                for (int h = 0; h < 2; ++h) { const int j = j0 + 2 * e2 + h; const float br = bbr[p * 16 + j], bi = bbi[p * 16 + j];
                    const float zr = ar * br - ai * bi, zi = ar * bi + ai * br; v[h] = (q == 0) ? zr : zi; }
                w[e2] = pk2(v[0], v[1]); }
        } else { w[0] = w[1] = w[2] = w[3] = 0u; }
        *(u32x4*)(WSm + ((size_t)(g * 256 + pr)) * KU + pc * 8) = (u32x4){w[0], w[1], w[2], w[3]};
    }
    if (q == 0 && tid < 64) { AL[(g * 64 + tid) * 2] = apr[LS * 64 + tid]; AL[(g * 64 + tid) * 2 + 1] = api[LS * 64 + tid]; }
}

__device__ __forceinline__ void norm_mod_phase(const float* src, bf16_t* dst, const float* gvec, const float* shp, const float* scp, int npart, const float* bias_sh, const float* bias_sc, int gw, int lane) {
    const int b = gw >> 9, r0 = gw & 511;
    f32x4 gs[8], sh[8];
#pragma unroll
    for (int j = 0; j < 8; ++j) { const int col = 4 * (j * 64 + lane);
        sh[j] = bias_sh ? *(const f32x4*)(bias_sh + col) : (f32x4){0.f, 0.f, 0.f, 0.f};
        gs[j] = bias_sc ? *(const f32x4*)(bias_sc + col) : (f32x4){0.f, 0.f, 0.f, 0.f}; }
#pragma unroll 1
    for (int s = 0; s < npart; ++s) {
#pragma unroll
        for (int j = 0; j < 8; ++j) { const int col = 4 * (j * 64 + lane);
            sh[j] += *(const f32x4*)(shp + (size_t)s * 4 * NMODC + (size_t)b * NMODC + col); gs[j] += *(const f32x4*)(scp + (size_t)s * 4 * NMODC + (size_t)b * NMODC + col); }
        asm volatile("" ::: "memory");
    }
#pragma unroll
    for (int j = 0; j < 8; ++j) { const int col = 4 * (j * 64 + lane); const f32x4 gvv = *(const f32x4*)(gvec + col); gs[j] = gvv * (gs[j] + 1.0f); }
    for (int k = 0; k < 16; ++k) {
        const size_t row = (size_t)b * SEQ + r0 + 512 * k;
        const f32x4* xr = (const f32x4*)(src + row * DM) + lane;
        f32x4 v[8]; float ss = 0.f;
#pragma unroll
        for (int j = 0; j < 8; ++j) { v[j] = xr[64 * j]; ss += (v[j][0] * v[j][0] + v[j][1] * v[j][1]) + (v[j][2] * v[j][2] + v[j][3] * v[j][3]); }
        const float rstd = rsqrtf(wave_sum(ss) * (1.f / DM) + EPS);
        u32x2* o8 = (u32x2*)(dst + row * DM) + lane;
#pragma unroll
        for (int j = 0; j < 8; ++j) { const f32x4 o = v[j] * rstd * gs[j] + sh[j]; o8[64 * j] = (u32x2){pk2(o[0], o[1]), pk2(o[2], o[3])}; }
    }
}

__device__ __forceinline__ s16x4 vtr(const LAS unsigned char* p) { return __builtin_bit_cast(s16x4, __builtin_amdgcn_ds_read_tr16_b64_v4i16((LAS s16x4*)p)); }
constexpr int AROW = 288, AVOFF = 256 * AROW;
__device__ __forceinline__ void attn_item(const bf16_t* QKV, bf16_t* ATTP, float* LSE, LAS unsigned char* lds, int it, int tid, int wave, int lane) {
    const int rj = it & 63, h = (it >> 6) & 7, b = (it >> 9) & 3, pi = it >> 11;
    const int dsh = 2 * pi, nbsh = 6 - dsh;
    const int r = rj >> nbsh, j = rj & ((1 << nbsh) - 1);
    const int fr = lane & 15, fq = lane >> 4;
    const size_t tokbase = (size_t)b * SEQ;
    __syncthreads();
    {
        u32x4 kv[8], vv[8];
#pragma unroll
        for (int i = 0; i < 8; ++i) { const int piece = tid + 512 * i, row = piece >> 4, pc = piece & 15; const int idx = 128 * (j - 1) + row;
            const size_t tok = tokbase + ((size_t)(idx >= 0 ? idx : 0) << dsh) + r; const bf16_t* src = QKV + tok * 3072 + 1024 + h * 128 + pc * 8;
            kv[i] = *(const u32x4*)src; vv[i] = *(const u32x4*)(src + 1024); }
#pragma unroll
        for (int i = 0; i < 8; ++i) { const int piece = tid + 512 * i, row = piece >> 4, pc = piece & 15;
            *(LAS u32x4*)(lds + row * AROW + pc * 16) = kv[i]; *(LAS u32x4*)(lds + AVOFF + row * AROW + pc * 16) = vv[i]; }
    }
    const int qi = 16 * wave + fr; const size_t qtok = tokbase + ((size_t)(128 * j + qi) << dsh) + r;
    bf16x8 qf[4];
    { const bf16_t* qp = QKV + qtok * 3072 + h * 128 + 8 * fq;
#pragma unroll
      for (int ks = 0; ks < 4; ++ks) qf[ks] = *(const bf16x8*)(qp + 32 * ks); }
    __syncthreads();
    const float slope2 = exp2f(-(float)(h + 1)) * (float)(1 << dsh) * 1.4426950408889634f;
    const float c0 = slope2 * ((float)(4 * fq - fr) - 128.f);
    f32x4 sacc[9];
#pragma unroll
    for (int kbi = 0; kbi < 9; ++kbi) { f32x4 acc;
#pragma unroll
        for (int i = 0; i < 4; ++i) acc[i] = fmaf(slope2, (float)(16 * kbi + i), c0);
        const LAS unsigned char* kp = lds + (16 * (wave + kbi) + fr) * AROW + fq * 16;
#pragma unroll
        for (int ks = 0; ks < 4; ++ks) { const bf16x8 kf = *(const LAS bf16x8*)(kp + ks * 64); acc = __builtin_amdgcn_mfma_f32_16x16x32_bf16(kf, qf[ks], acc, 0, 0, 0); }
        sacc[kbi] = acc; }
    const int rel0 = 4 * fq - fr;
#pragma unroll
    for (int i = 0; i < 4; ++i) { if (rel0 + i < 0) sacc[0][i] = -INFINITY; if (rel0 + i > 0) sacc[8][i] = -INFINITY; }
    if (j == 0) {
#pragma unroll
        for (int kbi = 0; kbi < 8; ++kbi) if (wave + kbi < 8) sacc[kbi] = (f32x4){-INFINITY, -INFINITY, -INFINITY, -INFINITY};
    }
    float mx = -INFINITY;
#pragma unroll
    for (int kbi = 0; kbi < 9; ++kbi)
#pragma unroll
        for (int i = 0; i < 4; ++i) mx = fmaxf(mx, sacc[kbi][i]);
    mx = fmaxf(mx, __shfl_xor(mx, 16)); mx = fmaxf(mx, __shfl_xor(mx, 32));
    float sum = 0.f;
#pragma unroll
    for (int kbi = 0; kbi < 9; ++kbi)
#pragma unroll
        for (int i = 0; i < 4; ++i) { const float p = __builtin_amdgcn_exp2f(sacc[kbi][i] - mx); sacc[kbi][i] = p; sum += p; }
    sum += __shfl_xor(sum, 16); sum += __shfl_xor(sum, 32);
    bf16x8 pf[5];
#pragma unroll
    for (int s = 0; s < 5; ++s) { const f32x4 pa = sacc[2 * s]; const f32x4 pb = (2 * s + 1 < 9) ? sacc[(2 * s + 1 < 9) ? 2 * s + 1 : 0] : (f32x4){0.f, 0.f, 0.f, 0.f};
        const u32x4 w = (u32x4){pk2(pa[0], pa[1]), pk2(pa[2], pa[3]), pk2(pb[0], pb[1]), pk2(pb[2], pb[3])}; pf[s] = __builtin_bit_cast(bf16x8, w); }
    f32x4 o[8];
#pragma unroll
    for (int eb = 0; eb < 8; ++eb) o[eb] = (f32x4){0.f, 0.f, 0.f, 0.f};
    const LAS unsigned char* vb = lds + AVOFF + (4 * fq + (fr >> 2)) * AROW + (4 * (fr & 3)) * 2;
#pragma unroll
    for (int s = 0; s < 5; ++s) { const int kbA = wave + 2 * s, kbB = (s < 4) ? kbA + 1 : kbA;
#pragma unroll
        for (int eb = 0; eb < 8; ++eb) { const s16x4 lo = vtr(vb + kbA * 16 * AROW + eb * 32), hi = vtr(vb + kbB * 16 * AROW + eb * 32);
            const bf16x8 vf = (bf16x8){lo[0], lo[1], lo[2], lo[3], hi[0], hi[1], hi[2], hi[3]};
            o[eb] = __builtin_amdgcn_mfma_f32_16x16x32_bf16(vf, pf[s], o[eb], 0, 0, 0); } }
    const float inv = 1.f / sum;
    bf16_t* op = ATTP + ((size_t)pi * MTOK + qtok) * AW + h * 128 + 4 * fq;
#pragma unroll
    for (int eb = 0; eb < 8; ++eb) *(u32x2*)(op + 16 * eb) = (u32x2){pk2(o[eb][0] * inv, o[eb][1] * inv), pk2(o[eb][2] * inv, o[eb][3] * inv)};
    if (fq == 0) LSE[((size_t)pi * MTOK + qtok) * 8 + h] = (mx + log2f(sum)) * 0.6931471805599453f;
}

#define XB_TMO      128
#define XB_XCNT(j)  (256  + 64 * (j))
#define XB_XSUB(j)  (1280 + 64 * (j))
#define XB_XGEN(j)  (2304 + 64 * (j))
#define XB_TOP      3328
#define XB_TOPGEN   3392
#define XCD_BAR_WORDS 3456
#define XB_SPIN_CAP (1u << 22)
__device__ __forceinline__ unsigned xb_ld(unsigned* p)              { return __hip_atomic_load(p, __ATOMIC_RELAXED, __HIP_MEMORY_SCOPE_AGENT); }
__device__ __forceinline__ unsigned xb_add(unsigned* p, unsigned v) { return __hip_atomic_fetch_add(p, v, __ATOMIC_RELAXED, __HIP_MEMORY_SCOPE_AGENT); }
__device__ __forceinline__ unsigned xb_xcc_id() { return (unsigned)__builtin_amdgcn_s_getreg((3 << 11) | 20) & 0xFu; }
#define XB_SPIN(cond, bar) do { unsigned _sp = 0; while (cond) { __builtin_amdgcn_s_sleep(1); \
    if ((++_sp & 255u) == 0u) { if (xb_ld(&(bar)[XB_TMO])) break; if (_sp > XB_SPIN_CAP) { atomicAdd(&(bar)[XB_TMO], 1u); break; } } } } while (0)
struct XcdBarrier { unsigned* bar; unsigned x; volatile LAS unsigned* st; };
__device__ __forceinline__ XcdBarrier xcd_barrier_post(unsigned* bar, volatile LAS unsigned* st) {
    XcdBarrier b; b.bar = bar; b.x = xb_xcc_id(); b.st = st;
    if (threadIdx.x == 0) (void)xb_add(&bar[XB_XCNT(b.x)], 1u);
    return b;
}
__device__ __forceinline__ void xcd_barrier_complete(unsigned* bar, unsigned x, unsigned& nloc, unsigned& nx) {
    const unsigned G = gridDim.x * gridDim.y * gridDim.z;
    unsigned sum, cnt, mine, sp = 0u;
    for (;;) {
        sum = 0u; cnt = 0u; mine = 0u;
#pragma unroll
        for (unsigned j = 0; j < 16; ++j) { const unsigned c = xb_ld(&bar[XB_XCNT(j)]); sum += c; cnt += (c > 0u) ? 1u : 0u; mine = (j == x) ? c : mine; }
        if (sum == G) break;
        __builtin_amdgcn_s_sleep(1);
        if ((++sp & 255u) == 0u) { if (xb_ld(&bar[XB_TMO])) break; if (sp > XB_SPIN_CAP) { atomicAdd(&bar[XB_TMO], 1u); break; } }
    }
    nloc = mine > 0u ? mine : 1u; nx = cnt > 0u ? cnt : 1u;
}
__device__ __forceinline__ void xcd_barrier(const XcdBarrier& b) {
    asm volatile("s_waitcnt vmcnt(0)" ::: "memory");
    __syncthreads();
    if (threadIdx.x == 0) {
        unsigned* bar = b.bar;
        __builtin_amdgcn_s_waitcnt(0);
        unsigned nloc = b.st[0], nx = b.st[1];
        if (nloc == 0u) { xcd_barrier_complete(bar, b.x, nloc, nx); b.st[0] = nloc; b.st[1] = nx; }
        const unsigned old = xb_add(&bar[XB_XSUB(b.x)], 1u);
        const unsigned gen = old / nloc;
        if (old + 1u == (gen + 1u) * nloc) {
            __builtin_amdgcn_fence(__ATOMIC_RELEASE, "agent");
            asm volatile("s_waitcnt vmcnt(0)" ::: "memory");
            const unsigned og = xb_add(&bar[XB_TOP], 1u);
            const unsigned tg = og / nx;
            if (og + 1u == (tg + 1u) * nx) xb_add(&bar[XB_TOPGEN], 1u);
            else XB_SPIN(xb_ld(&bar[XB_TOPGEN]) == tg, bar);
            __builtin_amdgcn_fence(__ATOMIC_ACQUIRE, "agent");
            xb_add(&bar[XB_XGEN(b.x)], 1u);
            asm volatile("s_waitcnt vmcnt(0)" ::: "memory");
        } else {
            XB_SPIN(xb_ld(&bar[XB_XGEN(b.x)]) == gen, bar);
            __builtin_amdgcn_fence(__ATOMIC_ACQUIRE, "agent");
            asm volatile("s_waitcnt vmcnt(0)" ::: "memory");
        }
    }
    __syncthreads();
}

__global__ void __launch_bounds__(512, 2) fwd_kernel(Args a) {
    extern __shared__ __attribute__((aligned(16))) unsigned char smem[];
    LAS unsigned char* lds = (LAS unsigned char*)smem;
    const int tid = threadIdx.x, lane = tid & 63, wave = __builtin_amdgcn_readfirstlane(tid >> 6);
    const int G = gridDim.x, bid = blockIdx.x;
    const int gw = bid * 8 + wave, NGW = G * 8;
    const int vbid = (G % 8 == 0) ? (bid % 8) * (G / 8) + bid / 8 : bid;
    unsigned char* ws = a.ws;
    float* MODP = (float*)(ws + WS_MODP); float* MOD = (float*)(ws + WS_MOD); float* AL = (float*)(ws + WS_AL);
    bf16_t* WIN = (bf16_t*)(ws + WS_WIN); bf16_t* WGLU = (bf16_t*)(ws + WS_WGLU); bf16_t* WOUT = (bf16_t*)(ws + WS_WOUT);
    bf16_t* WFF1 = (bf16_t*)(ws + WS_WFF1); bf16_t* WFF2 = (bf16_t*)(ws + WS_WFF2);
    bf16_t* TW = (bf16_t*)(ws + WS_TW); bf16_t* WSm = (bf16_t*)(ws + WS_WS);
    bf16_t* XN = (bf16_t*)(ws + WS_XN); bf16_t* ASSM = (bf16_t*)(ws + WS_ASSM); float* SLOC = (float*)(ws + WS_SLOC);
    bf16_t* QKV = (bf16_t*)(ws + WS_QKV); bf16_t* ATTP = (bf16_t*)(ws + WS_ATTP); float* LSE = (float*)(ws + WS_LSE);
    bf16_t* YACT = (bf16_t*)(ws + WS_YACT); bf16_t* SSMO = (bf16_t*)(ws + WS_SSMO); bf16_t* ACT = (bf16_t*)(ws + WS_ACT);
    const int lo = a.ph_lo, hi = a.ph_hi;
#define IN(k) (((PH_MASK >> (k)) & 1) && lo <= (k) && (k) < hi)
#if ONE_LAUNCH
    cg::grid_group grid = cg::this_grid();
    volatile LAS unsigned* xst = (volatile LAS unsigned*)(lds + LDS_BYTES - 4096);
    if (tid == 0) { xst[0] = 0u; xst[1] = 0u; }
    __syncthreads();
    const XcdBarrier xbar = xcd_barrier_post((unsigned*)(ws + WS_CTL) + 4096, xst);
    volatile LAS unsigned long long* tsl = (volatile LAS unsigned long long*)(lds + LDS_BYTES - 2048);
    if (TPROBE_PH >= 0 && bid == 0 && tid == 0) tsl[0] = __builtin_amdgcn_s_memrealtime();
    if (a.ph_hi > 1000) { __threadfence(); grid.sync(); }
#define SEAM(k) do { if (IN(k) && IN((k) + 1)) xcd_barrier(xbar); if (TPROBE_PH >= 0 && bid == 0 && tid == 0) tsl[(k) + 1] = __builtin_amdgcn_s_memrealtime(); } while (0)
#else
#define SEAM(k) do { } while (0)
#endif

    if (IN(0)) for (int rep = 0; rep < NREP(0); ++rep) {
        for (int it = bid; it < 768; it += G) p0_mod_item(a.in[I_C], a.in[I_WADA], a.in[I_BADA], MOD, lds, it, tid, wave, lane);
        if (TPROBE_PH >= 0 && bid == 0 && tid == 0) tsl[20] = __builtin_amdgcn_s_memrealtime();
        for (int it = bid; it < 256; it += G) p0_ssm_item(a, lds, it, tid);
        __syncthreads();
        if (TPROBE_PH >= 0 && bid == 0 && tid == 0) tsl[21] = __builtin_amdgcn_s_memrealtime();
        LAS float* scr = (LAS float*)(lds + wave * 16384);
        constexpr int T_IN = (DM / 64) * (INW / 32), T_GLU = (SW / 64) * (SW / 32), T_OUT = (DM / 64) * (DM / 32), T_FF1 = (DM / 64) * (DFF / 32), T_FF2 = (DFF / 64) * (DM / 32);
        for (int it = gw; it < T_IN + T_GLU + T_OUT + T_FF1 + T_FF2; it += NGW) {
            int r = it;
            if (r < T_IN) { p0_transpose_item(a.in[I_WIN], DM, INW, WIN, scr, r, lane); continue; } r -= T_IN;
            if (r < T_GLU) { p0_transpose_item(a.in[I_WGLU], SW, SW, WGLU, scr, r, lane); continue; } r -= T_GLU;
            if (r < T_OUT) { p0_transpose_item(a.in[I_WOUT], DM, DM, WOUT, scr, r, lane); continue; } r -= T_OUT;
            if (r < T_FF1) { p0_transpose_item(a.in[I_WFF1], DM, DFF, WFF1, scr, r, lane); continue; } r -= T_FF1;
            p0_transpose_item(a.in[I_WFF2], DFF, DM, WFF2, scr, r, lane);
        }
        if (TPROBE_PH >= 0 && bid == 0 && tid == 0) tsl[22] = __builtin_amdgcn_s_memrealtime();
    }
    SEAM(0);
    if (IN(1)) for (int rep = 0; rep < NREP(1); ++rep) {
        norm_mod_phase(a.in[I_X], XN, a.in[I_N1G], MOD + 0, MOD + DM, 1, nullptr, nullptr, gw, lane);
    }
    SEAM(1);
    if (IN(2)) for (int rep = 0; rep < NREP(2); ++rep) {
        pg8::Gemm g{XN, WIN, MTOK, INW, DM, DM, DM, 0, 0}; pg8::StaticOrder S; S.init(MTOK, INW, G, bid);
        pg8::EpiProj E{QKV, ASSM, a.in[I_QG], a.in[I_KG], (LAS float*)(lds + pg8::STAGE_BYTES)};
        pg8::gemm_phase<pg8::EpiProj>(lds, g, S, E);
    }
    SEAM(2);
    if (IN(3)) {
        pg8::Gemm g{ASSM, WSm, MSSM, 256, KU, KA, KU, RPG / 256, (size_t)256 * KU * 2}; pg8::StaticOrder S; S.init(MSSM, 256, G, bid);
        pg8::EpiSloc E{SLOC};
        pg8::gemm_phase<pg8::EpiSloc, true>(lds, g, S, E);
    }
    SEAM(3);
    if (IN(4)) {
        if (bid >= PFX_BLOCKS) {
            for (int k = 0; k < ATT_EARLY_PER; ++k) { const int eb = bid - PFX_BLOCKS, evb = (eb & 7) * ((G - PFX_BLOCKS) >> 3) + (eb >> 3);     const int it = ATT_NIT5 + evb + (G - PFX_BLOCKS) * k; if (it < ATT_NIT) attn_item(QKV, ATTP, LSE, lds, it, tid, wave, lane); }
            __syncthreads();
        } else for (int it = bid * 8 + wave; it < BATCH * NG; it += PFX_BLOCKS * 8) {
            const int b = it >> 6, g = it & 63; const int p = lane;
            const float alr = AL[(g * 64 + p) * 2], ali = AL[(g * 64 + p) * 2 + 1];
            float hr = 0.f, hi_ = 0.f;
            const size_t R0 = (size_t)g * RPG + (size_t)b * NSC;
            for (int sc0 = 0; sc0 < NSC; sc0 += 32) {
                float sr[32], si[32];
#pragma unroll
                for (int k = 0; k < 32; ++k) { sr[k] = SLOC[(R0 + sc0 + k) * 128 + p]; si[k] = SLOC[(R0 + sc0 + k) * 128 + 64 + p]; }
#pragma unroll
                for (int k = 0; k < 32; ++k) { bf16_t* dst = ASSM + (R0 + sc0 + k) * KA + KU + p;
                    dst[0] = (bf16_t)(pk2(hr, 0.f) & 0xffffu); dst[64] = (bf16_t)(pk2(hi_, 0.f) & 0xffffu);
                    const float nr = alr * hr - ali * hi_ + sr[k], ni = alr * hi_ + ali * hr + si[k]; hr = nr; hi_ = ni; }
            }
        }
    }
    SEAM(4);
    if (IN(5)) {
        for (int rep = 0; rep < NREP(12); ++rep) {
            pg8::Gemm g{ASSM, TW, MSSM, NT, KA, KA, KA, RPG / 256, (size_t)NT * KA * 2}; pg8::StaticOrder S; S.init(MSSM, NT, G, bid);
            pg8::EpiY E{ASSM, YACT, a.in[I_DSKIP]};
            pg8::gemm_phase<pg8::EpiY>(lds, g, S, E);
        }
        for (int rep = 0; rep < NREP(5); ++rep)
        for (int it = vbid; it < ATT_NIT5; it += G) attn_item(QKV, ATTP, LSE, lds, it, tid, wave, lane);
        __syncthreads();
    }
    SEAM(5);
    if (IN(6)) {
        pg8::Gemm g{YACT, WGLU, MTOK, SW, SW, SW, SW, 0, 0}; pg8::StaticOrder S; S.init(MTOK, SW, G, bid);
        pg8::EpiGlu E{YACT, SSMO, a.in[I_BGLU]};
        pg8::gemm_phase<pg8::EpiGlu>(lds, g, S, E);
    }
    SEAM(6);
    if (IN(7)) for (int rep = 0; rep < NREP(7); ++rep) {
        {
            float* BIAS2 = (float*)(ws + WS_BIAS2);
            u32x4 w[4][4];
#pragma unroll
            for (int c = 0; c < 4; ++c) { const u32x4* wr_ = (const u32x4*)(WFF1 + (size_t)(gw + NGW * c) * DM) + lane;
#pragma unroll
                for (int j = 0; j < 4; ++j) w[c][j] = (gw + NGW * c < DFF) ? wr_[64 * j] : (u32x4){0u, 0u, 0u, 0u}; }
#pragma unroll 1
            for (int b = 0; b < 4; ++b) {
                f32x4 s0[4], s1[4];
#pragma unroll
                for (int j = 0; j < 4; ++j) { const int k0 = (j * 64 + lane) * 8; s0[j] = *(const f32x4*)(MOD + (size_t)b * NMODC + 3 * DM + k0); s1[j] = *(const f32x4*)(MOD + (size_t)b * NMODC + 3 * DM + k0 + 4); }
                float acc[4];
#pragma unroll
                for (int c = 0; c < 4; ++c) { float a_ = 0.f;
#pragma unroll
                    for (int j = 0; j < 4; ++j) a_ += s0[j][0] * bflo(w[c][j].x) + s0[j][1] * bfhi(w[c][j].x) + s0[j][2] * bflo(w[c][j].y) + s0[j][3] * bfhi(w[c][j].y) + s1[j][0] * bflo(w[c][j].z) + s1[j][1] * bfhi(w[c][j].z) + s1[j][2] * bflo(w[c][j].w) + s1[j][3] * bfhi(w[c][j].w);
                    acc[c] = wave_sum(a_); }
                if (lane == 0) {
#pragma unroll
                    for (int c = 0; c < 4; ++c) if (gw + NGW * c < DFF) BIAS2[(size_t)b * DFF + gw + NGW * c] = acc[c]; }
            }
        }
        const float* aog = a.in[I_AOG]; const float* sog = a.in[I_SOG];
        for (int m = gw; m < MTOK; m += NGW) {
            float av[2][8], sv[2][8]; float assq = 0.f, sssq = 0.f;
#pragma unroll
            for (int i = 0; i < 2; ++i) { const int e0 = (i * 64 + lane) * 8, hh = e0 >> 7;
                const float l0 = LSE[((size_t)0 * MTOK + m) * 8 + hh], l1 = LSE[((size_t)1 * MTOK + m) * 8 + hh], l2 = LSE[((size_t)2 * MTOK + m) * 8 + hh];
                const float ml = fmaxf(l0, fmaxf(l1, l2)); float w0 = __expf(l0 - ml), w1 = __expf(l1 - ml), w2 = __expf(l2 - ml); const float iw = 1.f / (w0 + w1 + w2); w0 *= iw; w1 *= iw; w2 *= iw;
                const u32x4 x0 = *(const u32x4*)(ATTP + ((size_t)0 * MTOK + m) * AW + e0), x1 = *(const u32x4*)(ATTP + ((size_t)1 * MTOK + m) * AW + e0), x2 = *(const u32x4*)(ATTP + ((size_t)2 * MTOK + m) * AW + e0);
                av[i][0] = w0 * bflo(x0.x) + w1 * bflo(x1.x) + w2 * bflo(x2.x); av[i][1] = w0 * bfhi(x0.x) + w1 * bfhi(x1.x) + w2 * bfhi(x2.x);
                av[i][2] = w0 * bflo(x0.y) + w1 * bflo(x1.y) + w2 * bflo(x2.y); av[i][3] = w0 * bfhi(x0.y) + w1 * bfhi(x1.y) + w2 * bfhi(x2.y);
                av[i][4] = w0 * bflo(x0.z) + w1 * bflo(x1.z) + w2 * bflo(x2.z); av[i][5] = w0 * bfhi(x0.z) + w1 * bfhi(x1.z) + w2 * bfhi(x2.z);
                av[i][6] = w0 * bflo(x0.w) + w1 * bflo(x1.w) + w2 * bflo(x2.w); av[i][7] = w0 * bfhi(x0.w) + w1 * bfhi(x1.w) + w2 * bfhi(x2.w);
                const u32x4 y = *(const u32x4*)(SSMO + (size_t)m * SW + e0);
                sv[i][0] = bflo(y.x); sv[i][1] = bfhi(y.x); sv[i][2] = bflo(y.y); sv[i][3] = bfhi(y.y); sv[i][4] = bflo(y.z); sv[i][5] = bfhi(y.z); sv[i][6] = bflo(y.w); sv[i][7] = bfhi(y.w);
#pragma unroll
                for (int e = 0; e < 8; ++e) { assq += av[i][e] * av[i][e]; sssq += sv[i][e] * sv[i][e]; } }
            const float ra = rsqrtf(wave_sum(assq) * (1.f / AW) + EPS), rs = rsqrtf(wave_sum(sssq) * (1.f / SW) + EPS);
#pragma unroll
            for (int i = 0; i < 2; ++i) { const int e0 = (i * 64 + lane) * 8;
                const f32x4 ga0 = *(const f32x4*)(aog + e0), ga1 = *(const f32x4*)(aog + e0 + 4), gs0 = *(const f32x4*)(sog + e0), gs1 = *(const f32x4*)(sog + e0 + 4);
                u32x4 oa, os;
                oa.x = pk2(av[i][0] * ra * ga0[0], av[i][1] * ra * ga0[1]); oa.y = pk2(av[i][2] * ra * ga0[2], av[i][3] * ra * ga0[3]); oa.z = pk2(av[i][4] * ra * ga1[0], av[i][5] * ra * ga1[1]); oa.w = pk2(av[i][6] * ra * ga1[2], av[i][7] * ra * ga1[3]);
                os.x = pk2(sv[i][0] * rs * gs0[0], sv[i][1] * rs * gs0[1]); os.y = pk2(sv[i][2] * rs * gs0[2], sv[i][3] * rs * gs0[3]); os.z = pk2(sv[i][4] * rs * gs1[0], sv[i][5] * rs * gs1[1]); os.w = pk2(sv[i][6] * rs * gs1[2], sv[i][7] * rs * gs1[3]);
                *(u32x4*)(XN + (size_t)m * DM + e0) = oa; *(u32x4*)(XN + (size_t)m * DM + AW + e0) = os; }
        }
    }
    SEAM(7);
    if (IN(8)) {
        pg8::Gemm g{XN, WOUT, MTOK, DM, DM, DM, DM, 0, 0}; pg8::StaticOrder S; S.init(MTOK, DM, G, bid);
        pg8::EpiResN E{a.in[I_X], a.out, MOD + 2 * DM, a.in[I_N2G], MOD + 4 * DM, (bf16_t*)(ws + WS_H2), (float*)(ws + WS_SSQ)};
        pg8::gemm_phase<pg8::EpiResN>(lds, g, S, E);
    }
    SEAM(8);
    if (IN(10)) for (int rep = 0; rep < NREP(10); ++rep) {
        pg8::Gemm g{(const bf16_t*)(ws + WS_H2), WFF1, MTOK, DFF, DM, DM, DM, 0, 0}; pg8::StaticOrder S; S.init(MTOK, DFF, G, bid);
        pg8::EpiSqReluN E{ACT, (const float*)(ws + WS_SSQ), (const float*)(ws + WS_BIAS2)};
        pg8::gemm_phase<pg8::EpiSqReluN>(lds, g, S, E);
    }
    SEAM(10);
    if (IN(11)) {
        pg8::Gemm g{ACT, WFF2, MTOK, DM, DFF, DFF, DFF, 0, 0}; pg8::StaticOrder S; S.init(MTOK, DM, G, bid);
        pg8::EpiRes E{a.out, a.out, MOD + 5 * DM};
        pg8::gemm_phase<pg8::EpiRes>(lds, g, S, E);
    }
#if ONE_LAUNCH
    if (TPROBE_PH >= 0 && bid == 0 && tid == 0) {
        const unsigned long long tend = __builtin_amdgcn_s_memrealtime();
        tsl[NPH] = tend;
        int pa = TPROBE_PH, pb = TPROBE_PH + 1;
        if (TPROBE_PH == 100) { pa = 0; pb = 20; } if (TPROBE_PH == 101) { pa = 20; pb = 21; } if (TPROBE_PH == 102) { pa = 21; pb = 22; }
        if (TPROBE_PH == 10) pa = 9;
        const unsigned long long dt = tsl[pb] - tsl[pa];
        while (__builtin_amdgcn_s_memrealtime() - tend < dt * TPROBE_MULT) __builtin_amdgcn_s_sleep(8);
    }
#endif
#undef IN
#undef SEAM
}

extern "C" void kernel_launch(void* const* d_in, const int* in_sizes, int n_in, void* d_out, int out_size, void* d_ws, size_t ws_size, hipStream_t stream) {
    static int inited = 0;
    if (!inited) {
        if (n_in != 24 || ws_size < WS_END) { fprintf(stderr, "kernel_launch: unexpected inputs (n_in %d, ws %zu)\n", n_in, ws_size); inited = -1; return; }
        if (hipFuncSetAttribute((const void*)fwd_kernel, hipFuncAttributeMaxDynamicSharedMemorySize, LDS_BYTES) != hipSuccess) { fprintf(stderr, "kernel_launch: hipFuncSetAttribute failed\n"); inited = -1; return; }
        inited = 1;
    }
    if (inited < 0) return;
    (void)hipMemsetAsync((char*)d_ws + WS_CTL, 0, CTL_BYTES, stream);
    Args a{};
    for (int i = 0; i < 24; ++i) a.in[i] = (const float*)d_in[i];
    a.out = (float*)d_out; a.ws = (unsigned char*)d_ws;
    const int grid = 256;
#if ONE_LAUNCH
    a.ph_lo = 0; a.ph_hi = NPH;
    void* args[] = {&a};
    hipError_t e = hipLaunchCooperativeKernel((const void*)fwd_kernel, dim3(grid), dim3(512), args, LDS_BYTES, stream);
    if (e != hipSuccess) fprintf(stderr, "cooperative launch failed: %s\n", hipGetErrorString(e));
#else
    for (int ph = 0; ph < NPH; ++ph) { a.ph_lo = ph; a.ph_hi = ph + 1; hipLaunchKernelGGL(fwd_kernel, dim3(grid), dim3(512), LDS_BYTES, stream, a); }
#endif
}
```
